# Optimizing an MI355X kernel written in HIP

```python
import math
import jax
import jax.numpy as jnp
from jax import lax
import numpy as np

D_MODEL = 2048
BATCH = 16
SEQ = 256
DEPTH = 2
DEC_BATCH = 2
DEC_SEQ = 2048
PAST_LEN = 512

GRID_W = 64
ROPE_BASE = 10000.0
EPS = 1e-6
Q_BLOCK = 128
N_EVEN = (DEPTH + 1) // 2
N_ODD = DEPTH // 2
D_FF = 5632
N_MOD = 9
A_HEADS = 8
A_DH = 64
A_DV = 128
B_HEADS = 4
B_DK = 128
B_DV = 256
B_RANK = 16
B_TAU = 16.0
B_CHUNK = 32
A_QK_W = A_HEADS * 2 * A_DH
A_V_W = A_HEADS * A_DV
B_QK_W = B_HEADS * B_DK
B_V_W = B_HEADS * B_DV
AB_IN = 2 * A_QK_W + A_V_W + 2 * B_QK_W + 2 * B_V_W + 2 * B_RANK
AB_OUT = A_V_W + B_V_W
AB_SPLITS = (A_QK_W,
             2 * A_QK_W,
             2 * A_QK_W + A_V_W,
             2 * A_QK_W + A_V_W + B_QK_W,
             2 * A_QK_W + A_V_W + 2 * B_QK_W,
             2 * A_QK_W + A_V_W + 2 * B_QK_W + B_V_W,
             2 * A_QK_W + A_V_W + 2 * B_QK_W + 2 * B_V_W)
C_HEADS = 16
C_KV_HEADS = 4
C_DH = 128
C_WINDOW = 128
C_BLOCK = 128
C_IN = (C_HEADS + 2 * C_KV_HEADS) * C_DH
C_OUT = C_HEADS * C_DH
C_SPLITS = (C_HEADS * C_DH, (C_HEADS + C_KV_HEADS) * C_DH)

kernel_name = 'hybrid_prefix_diffusion_trunk_step'


def rms_norm(x, g):
    xf = x.astype(jnp.float32)
    y = xf * lax.rsqrt(jnp.mean(xf * xf, axis=-1, keepdims=True) + EPS)
    return (y * g.astype(jnp.float32)).astype(x.dtype)


def adaln(cond, w, b):
    return (jax.nn.silu(cond) @ w + b).reshape(cond.shape[0], N_MOD, D_MODEL)


def modulate(h, shift, scale):
    return h * (1.0 + scale[:, None, :]) + shift[:, None, :]


def half_ffn(x, mod, i, g, w_in, w_out):
    h = modulate(rms_norm(x, g), mod[:, i], mod[:, i + 1])
    gate, up = jnp.split(h @ w_in, 2, axis=-1)
    return x + 0.5 * mod[:, i + 2][:, None, :] * ((jax.nn.silu(gate) * up) @ w_out)


def heads(t, n_heads):
    b, n, _ = t.shape
    return t.reshape(b, n, n_heads, -1).transpose(0, 2, 1, 3)


def merge_heads(t):
    b, h, n, d = t.shape
    return t.transpose(0, 2, 1, 3).reshape(b, n, h * d)


def axial_angles(n, head_dim):
    rows = n // GRID_W
    row = jnp.repeat(jnp.arange(rows, dtype=jnp.float32), GRID_W)
    col = jnp.tile(jnp.arange(GRID_W, dtype=jnp.float32), rows)
    d_axis = head_dim // 2
    inv = ROPE_BASE ** (-jnp.arange(0, d_axis, 2, dtype=jnp.float32) / d_axis)
    return row[:, None] * inv[None, :], col[:, None] * inv[None, :]


def rotate(x, ang):
    x1, x2 = jnp.split(x, 2, axis=-1)
    cos, sin = jnp.cos(ang), jnp.sin(ang)
    return jnp.concatenate([x1 * cos - x2 * sin, x1 * sin + x2 * cos], axis=-1)


def axial_rope(x, angles):
    ang_r, ang_c = angles
    xr, xc = jnp.split(x.astype(jnp.float32), 2, axis=-1)
    return jnp.concatenate([rotate(xr, ang_r), rotate(xc, ang_c)], axis=-1).astype(x.dtype)


def sweep_query_blocks(fn, *qs):
    b, h, n, _ = qs[0].shape
    nb = n // Q_BLOCK
    qb = tuple(jnp.moveaxis(q.reshape(b, h, nb, Q_BLOCK, q.shape[-1]), 2, 0) for q in qs)
    out = lax.map(lambda blk: fn(*blk), qb)
    return jnp.moveaxis(out, 0, 2).reshape(b, h, n, out.shape[-1])


def diff_lambda(lam_p, layer):
    lam_init = 0.8 - 0.6 * math.exp(-0.3 * layer)
    lp = lam_p.astype(jnp.float32)
    lam = jnp.exp(jnp.sum(lp[0] * lp[1])) - jnp.exp(jnp.sum(lp[2] * lp[3])) + lam_init
    return lam, lam_init


def diff_attention(q1, q2, k1, k2, v, lam):
    scale = A_DH ** -0.5

    def blk(a, b):
        s1 = jnp.einsum('bhqd,bhkd->bhqk', a, k1).astype(jnp.float32) * scale
        s2 = jnp.einsum('bhqd,bhkd->bhqk', b, k2).astype(jnp.float32) * scale
        p = jax.nn.softmax(s1, axis=-1) - lam * jax.nn.softmax(s2, axis=-1)
        return jnp.einsum('bhqk,bhkd->bhqd', p.astype(v.dtype), v)

    return sweep_query_blocks(blk, q1, q2)


def gla_chunk_scan(q, k, v, log_a, s0):
    b, h, n, _ = q.shape
    dv = v.shape[-1]
    nc = n // B_CHUNK

    def chunks(t):
        return jnp.moveaxis(t.astype(jnp.float32).reshape(b, h, nc, B_CHUNK, t.shape[-1]), 2, 0)

    causal = jnp.tril(jnp.ones((B_CHUNK, B_CHUNK), dtype=bool))[:, :, None]

    def step(state, inp):
        qc, kc, vc, gc = inp
        cum = jnp.cumsum(gc, axis=2)
        cum_last = cum[:, :, -1:, :]
        inter = jnp.einsum('bhtd,bhde->bhte', qc * jnp.exp(cum), state)
        rel = jnp.where(causal, cum[:, :, :, None, :] - cum[:, :, None, :, :], -jnp.inf)
        scores = jnp.einsum('bhtd,bhsd,bhtsd->bhts', qc, kc, jnp.exp(rel))
        intra = jnp.einsum('bhts,bhse->bhte', scores, vc)
        new_state = (jnp.exp(cum_last[:, :, 0, :])[..., None] * state
                     + jnp.einsum('bhsd,bhse->bhde', kc * jnp.exp(cum_last - cum), vc))
        return new_state, inter + intra

    s_fin, o = lax.scan(step, s0.astype(jnp.float32),
                        (chunks(q), chunks(k), chunks(v), chunks(log_a)))
    o = jnp.moveaxis(o, 0, 2).reshape(b, h, n, dv)
    return o.astype(v.dtype), s_fin


def gla_bidirectional(q, k, v, la_f, la_b, s_f, s_b):
    o_f, s_f_new = gla_chunk_scan(q, k, v, la_f, s_f)
    flip = lambda t: jnp.flip(t, axis=2)
    o_b, s_b_new = gla_chunk_scan(flip(q), flip(k), flip(v), flip(la_b), s_b)
    return o_f + flip(o_b), s_f_new, s_b_new


def ab_project(h, w_in, alpha_w, alpha_b):
    a_q, a_k, a_v, b_q, b_k, b_v, b_r, b_low = jnp.split(h @ w_in, AB_SPLITS, axis=-1)
    a_q = heads(a_q, A_HEADS)
    a_k = heads(a_k, A_HEADS)
    attn = (a_q[..., :A_DH], a_q[..., A_DH:], a_k[..., :A_DH], a_k[..., A_DH:], heads(a_v, A_HEADS))
    low_f, low_b = jnp.split(b_low, 2, axis=-1)
    la_f = jax.nn.log_sigmoid((low_f @ alpha_w[0] + alpha_b[0]).astype(jnp.float32)) / B_TAU
    la_b = jax.nn.log_sigmoid((low_b @ alpha_w[1] + alpha_b[1]).astype(jnp.float32)) / B_TAU
    rec = (heads(b_q, B_HEADS) * (B_DK ** -0.5), heads(b_k, B_HEADS), heads(b_v, B_HEADS), b_r,
           heads(la_f, B_HEADS), heads(la_b, B_HEADS))
    return attn, rec


def ab_merge(a_o, b_o, b_r, lam_init, subln_g, bnorm_g, w_out):
    a_out = merge_heads(rms_norm(a_o, subln_g) * (1.0 - lam_init))
    b_out = merge_heads(rms_norm(b_o, bnorm_g)) * jax.nn.silu(b_r)
    return jnp.concatenate([a_out, b_out], axis=-1) @ w_out


def ab_mixer_context(h, lam, lam_init, w_in, w_out, subln_g, alpha_w, alpha_b, bnorm_g):
    (q1, q2, k1, k2, v), (bq, bk, bv, br, la_f, la_b) = ab_project(h, w_in, alpha_w, alpha_b)
    a_o = diff_attention(q1, q2, k1, k2, v, lam)
    zero = jnp.zeros((h.shape[0], B_HEADS, B_DK, B_DV), jnp.float32)
    b_o, s_f, s_b = gla_bidirectional(bq, bk, bv, la_f, la_b, zero, zero)
    out = ab_merge(a_o, b_o, br, lam_init, subln_g, bnorm_g, w_out)
    return out, (jnp.concatenate([k1, k2], axis=-1), v, s_f, s_b)


def ab_mixer_latent(h, ctx_k, ctx_v, s_f, s_b, ang, lam, lam_init, w_in, w_out, subln_g,
                    alpha_w, alpha_b, bnorm_g):
    (q1, q2, k1, k2, v), (bq, bk, bv, br, la_f, la_b) = ab_project(h, w_in, alpha_w, alpha_b)
    q1, q2, k1, k2 = (axial_rope(q1, ang), axial_rope(q2, ang), axial_rope(k1, ang), axial_rope(k2, ang))
    ck1, ck2 = jnp.split(ctx_k, 2, axis=-1)
    a_o = diff_attention(q1, q2,
                         jnp.concatenate([ck1, k1], axis=2),
                         jnp.concatenate([ck2, k2], axis=2),
                         jnp.concatenate([ctx_v, v], axis=2), lam)
    b_o, _, _ = gla_bidirectional(bq, bk, bv, la_f, la_b, s_f, s_b)
    return ab_merge(a_o, b_o, br, lam_init, subln_g, bnorm_g, w_out)


def c_project(h, w_in):
    q, k, v = jnp.split(h @ w_in, C_SPLITS, axis=-1)
    return heads(q, C_HEADS), heads(k, C_KV_HEADS), heads(v, C_KV_HEADS)


def sink_dense_attention(q, k, v, sink):
    b, hq, _, dh = q.shape
    hkv = k.shape[1]
    g = hq // hkv
    scale = dh ** -0.5
    sink_g = sink.astype(jnp.float32).reshape(hkv, g)

    def blk(qb):
        qg = qb.reshape(b, hkv, g, Q_BLOCK, dh)
        s = jnp.einsum('bhgqd,bhkd->bhgqk', qg, k).astype(jnp.float32) * scale
        sk = jnp.broadcast_to(sink_g[None, :, :, None, None], s.shape[:-1] + (1,))
        p = jax.nn.softmax(jnp.concatenate([sk, s], axis=-1), axis=-1)[..., 1:]
        o = jnp.einsum('bhgqk,bhkd->bhgqd', p.astype(v.dtype), v)
        return o.reshape(b, hq, Q_BLOCK, dh)

    return sweep_query_blocks(blk, q)


def window_sink_attention(q, k, v, kc, vc, sink):
    b, hq, n, dh = q.shape
    hkv = k.shape[1]
    g = hq // hkv
    nb = n // C_BLOCK
    nc = kc.shape[2]
    scale = dh ** -0.5
    qg = q.reshape(b, hkv, g, nb, C_BLOCK, dh)
    pad = ((0, 0), (0, 0), (C_BLOCK, C_BLOCK), (0, 0))

    def band(t):
        return jnp.concatenate(
            [t[:, :, j * C_BLOCK: j * C_BLOCK + n].reshape(b, hkv, nb, C_BLOCK, dh) for j in range(3)],
            axis=3)

    kb, vb = band(jnp.pad(k, pad)), band(jnp.pad(v, pad))
    blk_idx = jnp.arange(nb)[:, None] * C_BLOCK
    qpos = blk_idx + jnp.arange(C_BLOCK)[None, :]
    kpos = blk_idx - C_BLOCK + jnp.arange(3 * C_BLOCK)[None, :]
    valid = ((kpos[:, None, :] >= 0) & (kpos[:, None, :] < n)
             & (jnp.abs(qpos[:, :, None] - kpos[:, None, :]) <= C_WINDOW))
    s_band = jnp.einsum('bhgnqd,bhnkd->bhgnqk', qg, kb).astype(jnp.float32) * scale
    s_band = jnp.where(valid, s_band, -jnp.inf)
    s_ctx = jnp.einsum('bhgnqd,bhkd->bhgnqk', qg, kc).astype(jnp.float32) * scale
    sink_g = sink.astype(jnp.float32).reshape(hkv, g)
    sk = jnp.broadcast_to(sink_g[None, :, :, None, None, None], s_ctx.shape[:-1] + (1,))
    p = jax.nn.softmax(jnp.concatenate([sk, s_ctx, s_band], axis=-1), axis=-1)
    p_ctx = p[..., 1:1 + nc].astype(v.dtype)
    p_band = p[..., 1 + nc:].astype(v.dtype)
    o = (jnp.einsum('bhgnqk,bhkd->bhgnqd', p_ctx, vc)
         + jnp.einsum('bhgnqk,bhnkd->bhgnqd', p_band, vb))
    return o.reshape(b, hq, n, dh)


def c_mixer_context(h, w_in, w_out, sink):
    q, k, v = c_project(h, w_in)
    o = sink_dense_attention(q, k, v, sink)
    return merge_heads(o) @ w_out, (k, v)


def c_mixer_latent(h, ctx_k, ctx_v, ang, w_in, w_out, sink):
    q, k, v = c_project(h, w_in)
    q, k = axial_rope(q, ang), axial_rope(k, ang)
    o = window_sink_attention(q, k, v, ctx_k, ctx_v, sink)
    return merge_heads(o) @ w_out


def setup_inputs(seed: int = 0) -> dict:
    key = jax.random.key(seed)
    ks = jax.random.split(key, 26)

    def nrm(k, shape, s=1.0):
        return s * jax.random.normal(k, shape, dtype=jnp.float32)

    return {
        'x_prompt': nrm(ks[0], (BATCH, SEQ, D_MODEL)),
        'x_sample': nrm(ks[1], (DEC_BATCH, DEC_SEQ, D_MODEL)),
        'cache_a_k': nrm(ks[2], (DEC_BATCH, N_EVEN, A_HEADS, PAST_LEN, 2 * A_DH)),
        'cache_a_v': nrm(ks[3], (DEC_BATCH, N_EVEN, A_HEADS, PAST_LEN, A_DV)),
        'state_b_fwd': nrm(ks[4], (DEC_BATCH, N_EVEN, B_HEADS, B_DK, B_DV), 0.5),
        'state_b_bwd': nrm(ks[5], (DEC_BATCH, N_EVEN, B_HEADS, B_DK, B_DV), 0.5),
        'cache_c_k': nrm(ks[6], (DEC_BATCH, N_ODD, C_KV_HEADS, PAST_LEN, C_DH)),
        'cache_c_v': nrm(ks[7], (DEC_BATCH, N_ODD, C_KV_HEADS, PAST_LEN, C_DH)),
        'c': nrm(ks[8], (DEC_BATCH, D_MODEL)),
        'c_ctx': nrm(ks[9], (D_MODEL,)),
        'ada_w': nrm(ks[10], (DEPTH, D_MODEL, N_MOD * D_MODEL), D_MODEL ** -0.5),
        'ada_b': nrm(ks[11], (DEPTH, N_MOD * D_MODEL), 0.02),
        'norm_g': 1.0 + nrm(ks[12], (DEPTH, 3, D_MODEL), 0.02),
        'ffn_w_in': nrm(ks[13], (DEPTH, 2, D_MODEL, 2 * D_FF), D_MODEL ** -0.5),
        'ffn_w_out': nrm(ks[14], (DEPTH, 2, D_FF, D_MODEL), D_FF ** -0.5),
        'ab_w_in': nrm(ks[15], (N_EVEN, D_MODEL, AB_IN), D_MODEL ** -0.5),
        'ab_w_out': nrm(ks[16], (N_EVEN, AB_OUT, D_MODEL), AB_OUT ** -0.5),
        'a_lambda': nrm(ks[17], (N_EVEN, 4, A_DH), 0.1),
        'a_subln_g': 1.0 + nrm(ks[18], (N_EVEN, A_DV), 0.02),
        'b_alpha_w': nrm(ks[19], (N_EVEN, 2, B_RANK, B_QK_W), B_RANK ** -0.5),
        'b_alpha_b': nrm(ks[20], (N_EVEN, 2, B_QK_W), 0.02),
        'b_norm_g': 1.0 + nrm(ks[21], (N_EVEN, B_DV), 0.02),
        'c_w_in': nrm(ks[22], (N_ODD, D_MODEL, C_IN), D_MODEL ** -0.5),
        'c_w_out': nrm(ks[23], (N_ODD, C_OUT, D_MODEL), C_OUT ** -0.5),
        'c_sink': nrm(ks[24], (N_ODD, C_HEADS), 0.5),
        'final_g': 1.0 + nrm(ks[25], (D_MODEL,), 0.02),
    }


def reference(x_prompt, x_sample, cache_a_k, cache_a_v, state_b_fwd, state_b_bwd, cache_c_k,
              cache_c_v, c, c_ctx, ada_w, ada_b, norm_g, ffn_w_in, ffn_w_out, ab_w_in, ab_w_out,
              a_lambda, a_subln_g, b_alpha_w, b_alpha_b, b_norm_g, c_w_in, c_w_out, c_sink, final_g):
    n_lat = x_sample.shape[1]
    ang_a = axial_angles(n_lat, A_DH)
    ang_c = axial_angles(n_lat, C_DH)
    xp, xs = x_prompt, x_sample
    a_k_list, a_v_list, b_f_list, b_b_list, c_k_list, c_v_list = [], [], [], [], [], []
    for l in range(DEPTH):
        mod_p = adaln(c_ctx[None, :], ada_w[l], ada_b[l])
        mod_s = adaln(c, ada_w[l], ada_b[l])
        xp = half_ffn(xp, mod_p, 0, norm_g[l, 0], ffn_w_in[l, 0], ffn_w_out[l, 0])
        xs = half_ffn(xs, mod_s, 0, norm_g[l, 0], ffn_w_in[l, 0], ffn_w_out[l, 0])
        hp = modulate(rms_norm(xp, norm_g[l, 1]), mod_p[:, 3], mod_p[:, 4])
        hs = modulate(rms_norm(xs, norm_g[l, 1]), mod_s[:, 3], mod_s[:, 4])
        if l % 2 == 0:
            e = l // 2
            lam, lam_init = diff_lambda(a_lambda[e], l)
            mix_p, (ak, av, sf, sb) = ab_mixer_context(
                hp, lam, lam_init, ab_w_in[e], ab_w_out[e], a_subln_g[e], b_alpha_w[e],
                b_alpha_b[e], b_norm_g[e])
            mix_s = ab_mixer_latent(
                hs, cache_a_k[:, e], cache_a_v[:, e], state_b_fwd[:, e], state_b_bwd[:, e], ang_a,
                lam, lam_init, ab_w_in[e], ab_w_out[e], a_subln_g[e], b_alpha_w[e], b_alpha_b[e],
                b_norm_g[e])
            a_k_list.append(ak)
            a_v_list.append(av)
            b_f_list.append(sf)
            b_b_list.append(sb)
        else:
            o = l // 2
            mix_p, (ck, cv) = c_mixer_context(hp, c_w_in[o], c_w_out[o], c_sink[o])
            mix_s = c_mixer_latent(hs, cache_c_k[:, o], cache_c_v[:, o], ang_c, c_w_in[o],
                                   c_w_out[o], c_sink[o])
            c_k_list.append(ck)
            c_v_list.append(cv)
        xp = xp + mod_p[:, 5][:, None, :] * mix_p
        xs = xs + mod_s[:, 5][:, None, :] * mix_s
        xp = half_ffn(xp, mod_p, 6, norm_g[l, 2], ffn_w_in[l, 1], ffn_w_out[l, 1])
        xs = half_ffn(xs, mod_s, 6, norm_g[l, 2], ffn_w_in[l, 1], ffn_w_out[l, 1])
    y_prompt = rms_norm(xp, final_g)
    y_sample = rms_norm(xs, final_g)
    new_a_k = jnp.stack(a_k_list, axis=1)
    new_a_v = jnp.stack(a_v_list, axis=1)
    new_b_fwd = jnp.stack(b_f_list, axis=1)
    new_b_bwd = jnp.stack(b_b_list, axis=1)
    new_c_k = jnp.stack(c_k_list, axis=1)
    new_c_v = jnp.stack(c_v_list, axis=1)
    return (y_prompt, y_sample, new_a_k, new_a_v, new_b_fwd, new_b_bwd, new_c_k, new_c_v)
```

```cpp
#include <hip/hip_runtime.h>
#include <hip/hip_cooperative_groups.h>
#include <stdint.h>
#include <string.h>
#include <stdio.h>
namespace cg = cooperative_groups;

typedef unsigned short bf16_t;
typedef short bf16x8 __attribute__((ext_vector_type(8)));
typedef float f32x4 __attribute__((ext_vector_type(4)));
typedef float f32x16 __attribute__((ext_vector_type(16)));
typedef unsigned u32x4 __attribute__((ext_vector_type(4)));
typedef unsigned u32x2 __attribute__((ext_vector_type(2)));
#define LAS __attribute__((address_space(3)))

#ifndef N_LAUNCH_SPLIT
#define N_LAUNCH_SPLIT 0
#endif

constexpr int NTOK = 8192, DM = 2048, DFF = 5632, NMODW = 18432;
constexpr float LOG2E = 1.4426950408889634f;
constexpr float LOG2_ROPE = 13.287712379549449f;

struct TJob { const float* src; bf16_t* dst; long long sbs, dbs; int lds, K, N, ldd, map, nbatch, tile0, pad; };

struct Params {
    const float *x_prompt, *x_sample, *cache_a_k, *cache_a_v, *state_f, *state_b, *cache_c_k, *cache_c_v, *c, *c_ctx;
    const float *ada_w, *ada_b, *norm_g, *ffn_w_in, *ffn_w_out, *ab_w_in, *ab_w_out, *a_lambda, *a_subln_g, *alpha_w, *alpha_b, *b_norm_g;
    const float *c_w_in, *c_w_out, *c_sink, *final_g;
    float *y, *new_a_k, *new_a_v, *new_b_f, *new_b_b, *new_c_k, *new_c_v;
    float* mods;
    float* xres;
    bf16_t* h;
    bf16_t* act;
    bf16_t* mo;
    bf16_t* wt_in;
    bf16_t* wt_out;
    bf16_t* wt_ab;
    bf16_t* wt_abo;
    bf16_t* wt_c;
    bf16_t* wt_co;
    bf16_t *qa_p, *ka_p, *vta_p;
    bf16_t *qa_s, *ka_s, *vta_s;
    bf16_t *qc_p, *kc_p, *vtc_p;
    bf16_t *qc_s, *kc_s, *vtc_s;
    bf16_t* pb;
    bf16_t* bvt;
    float* la;
    float *of, *ob;
    float* park;
    TJob jobs[14];
    int n_ttiles, phase_lo, phase_hi, pad0;
};

typedef const __attribute__((address_space(4))) Params CParams;

__device__ __forceinline__ unsigned f2bf(float f) { unsigned u = __float_as_uint(f); u += 0x7FFFu + ((u >> 16) & 1u); return u >> 16; }
__device__ __forceinline__ unsigned pk2(float lo, float hi) { return f2bf(lo) | (f2bf(hi) << 16); }
__device__ __forceinline__ float bf2f(bf16_t b) { return __uint_as_float(((unsigned)b) << 16); }
__device__ __forceinline__ float silu_f(float x) { return x / (1.0f + __expf(-x)); }
__device__ __forceinline__ int cond_of_row(int row) { return row < 4096 ? 0 : 1 + ((row - 4096) >> 11); }
__device__ __forceinline__ const float* modp(CParams& p, int kh, int l, int c) { return p.mods + (size_t)((kh * 2 + l) * 3 + c) * NMODW; }
__device__ __forceinline__ f32x4 mod4(CParams& p, int l, int c, int i, int col) {
    const f32x4 a = *(const f32x4*)(modp(p, 0, l, c) + i * DM + col), b = *(const f32x4*)(modp(p, 1, l, c) + i * DM + col);
    return a + b;
}
__device__ __forceinline__ f32x16 mfma32(bf16x8 a, bf16x8 b, f32x16 c) { return __builtin_amdgcn_mfma_f32_32x32x16_bf16(a, b, c, 0, 0, 0); }
__device__ __forceinline__ bf16x8 pack8(const f32x16& s, int base) {
    u32x4 r; r[0] = pk2(s[base + 0], s[base + 1]); r[1] = pk2(s[base + 2], s[base + 3]); r[2] = pk2(s[base + 4], s[base + 5]); r[3] = pk2(s[base + 6], s[base + 7]);
    return __builtin_bit_cast(bf16x8, r);
}
__device__ __forceinline__ float xor32(float v) { return __shfl_xor(v, 32, 64); }

namespace pg8 {
constexpr int BM = 256, BK = 64, HALF = 128, HTB = HALF * BK * 2, STAGE_BYTES = 8 * HTB, NXCD = 8, WGM = 8;
__device__ __forceinline__ int lds_byte(int r, int c) { const int st = (r >> 4) * 2 + (c >> 5), rr = r & 15, cc = c & 31, ob = rr * 64 + cc * 2; return st * 1024 + (ob ^ (((ob >> 9) & 1) << 5)); }
__device__ __forceinline__ void stage_rc(int b, int& R, int& C) { const int st = b / 1024, sb = b % 1024, swz = sb ^ (((sb >> 9) & 1) << 5); R = (st >> 1) * 16 + swz / 64; C = (st & 1) * 32 + (swz % 64) / 2; }
struct Unit { int pm, pn; };
struct Gemm { const bf16_t* A; const bf16_t* Bt; int M, N, K; };
struct StaticOrder {
    int nM, nN, nwg, G, c;
    __device__ void init(int M, int N, int G_, int c_) { nM = M / BM; nN = N / BM; nwg = nM * nN; G = G_; c = c_; }
    __device__ bool next(int i, Unit& u) const {
        const long L = (long)i * G + c; if (L >= nwg) return false;
        int wgid = (int)L; { const int q = nwg / NXCD, r = nwg % NXCD, xcd = wgid % NXCD, off = wgid / NXCD; wgid = (xcd < r ? xcd * (q + 1) : r * (q + 1) + (xcd - r) * q) + off; }
        const int nig = WGM * nN, gid = wgid / nig, fm = gid * WGM, gsz = (nM - fm) < WGM ? (nM - fm) : WGM;
        u.pm = fm + ((wgid % nig) % gsz); u.pn = (wgid % nig) / gsz; return true;
    }
};
template <class Epi>
__device__ __forceinline__ void gemm_phase(LAS unsigned char* lds, const Gemm g, const StaticOrder& S, const Epi& E) {
    const int tid = threadIdx.x, wid = __builtin_amdgcn_readfirstlane(tid >> 6), lane = tid & 63, wr = wid >> 2, wc = wid & 3, fr = lane & 15, fq = lane >> 4;
    const int K = g.K, nt = K / BK;
    unsigned voffA[2], voffB[2];
#pragma unroll
    for (int i = 0; i < 2; ++i) { int R, C; stage_rc(tid * 16 + i * 8192, R, C); voffA[i] = (unsigned)(R * K + C) * 2u; voffB[i] = voffA[i]; }
    const size_t kstep = (size_t)(BK * 2);
    const size_t hstep = (size_t)HALF * K * 2;
    const size_t tstep = 2 * hstep;
    const unsigned ldsw = (unsigned)wid * 1024u;
    const int aoff = lds_byte(wr * 64 + fr, fq * 8), boff = lds_byte(wc * 32 + fr, fq * 8);
#define PG8_SA(b, h) (((b) * 2 + (h)) * HTB)
#define PG8_SB(b, h) ((4 + (b) * 2 + (h)) * HTB)
#define PG8_STAGE(bufoff, gbase, voff) do { _Pragma("unroll") for (int _i = 0; _i < 2; ++_i) \
        __builtin_amdgcn_global_load_lds((const unsigned*)((const char*)(gbase) + (voff)[_i]), (LAS unsigned*)(lds + (bufoff) + ldsw + _i * 8192), 16, 0, 0); } while (0)
#define PG8_LDA(dst, b, h) do { _Pragma("unroll") for (int m = 0; m < 4; ++m) _Pragma("unroll") for (int k = 0; k < 2; ++k) dst[m][k] = *(const LAS bf16x8*)(lds + PG8_SA(b, h) + aoff + m * 2048 + k * 1024); } while (0)
#define PG8_LDB(dst, b, h) do { _Pragma("unroll") for (int n = 0; n < 2; ++n) _Pragma("unroll") for (int k = 0; k < 2; ++k) dst[n][k] = *(const LAS bf16x8*)(lds + PG8_SB(b, h) + boff + n * 2048 + k * 1024); } while (0)
#define PG8_MMA(ai, bj, At, Bt) do { __builtin_amdgcn_s_setprio(1); _Pragma("unroll") for (int m = 0; m < 4; ++m) _Pragma("unroll") for (int n = 0; n < 2; ++n) _Pragma("unroll") for (int k = 0; k < 2; ++k) \
        acc[ai][bj][m][n] = __builtin_amdgcn_mfma_f32_16x16x32_bf16(Bt[n][k], At[m][k], acc[ai][bj][m][n], 0, 0, 0); __builtin_amdgcn_s_setprio(0); } while (0)
#define PG8_WAIT_V(n) asm volatile("s_waitcnt vmcnt(" #n ")" ::: "memory")
#define PG8_WAIT_L(n) asm volatile("s_waitcnt lgkmcnt(" #n ")" ::: "memory")
#define PG8_BAR __builtin_amdgcn_s_barrier()
#define PG8_SCHED __builtin_amdgcn_sched_barrier(0)
    Unit cur, nxt; int ui = 0;
    if (!S.next(0, cur)) return;
    f32x4 acc[2][2][4][2];
#pragma unroll
    for (int a = 0; a < 2; ++a)
#pragma unroll
        for (int b = 0; b < 2; ++b)
#pragma unroll
            for (int m = 0; m < 4; ++m)
#pragma unroll
                for (int n = 0; n < 2; ++n) acc[a][b][m][n] = (f32x4){0.f, 0.f, 0.f, 0.f};
    bf16x8 At[4][2], B0[2][2], B1[2][2];
    const char* cA = (const char*)g.A + (size_t)cur.pm * tstep; const char* cB = (const char*)g.Bt + (size_t)cur.pn * tstep;
    PG8_STAGE(PG8_SB(0, 0), cB, voffB); PG8_STAGE(PG8_SA(0, 0), cA, voffA); PG8_STAGE(PG8_SB(0, 1), cB + hstep, voffB); PG8_STAGE(PG8_SA(0, 1), cA + hstep, voffA);
    if (wr == 1) PG8_BAR;
    PG8_WAIT_V(4); PG8_BAR;
    PG8_STAGE(PG8_SB(1, 0), cB + kstep, voffB); PG8_STAGE(PG8_SA(1, 0), cA + kstep, voffA); PG8_STAGE(PG8_SB(1, 1), cB + hstep + kstep, voffB);
    PG8_WAIT_V(6); PG8_BAR;
    for (;;) {
        const bool has_next = S.next(ui + 1, nxt);
        const char* nA = has_next ? (const char*)g.A + (size_t)nxt.pm * tstep : cA; const char* nB = has_next ? (const char*)g.Bt + (size_t)nxt.pn * tstep : cB;
        for (int t = 0; t < nt; t += 2) {
            const bool last = (t == nt - 2);
            const char* a1 = cA + (size_t)(t + 1) * kstep;
            const char* a2 = last ? nA : cA + (size_t)(t + 2) * kstep; const char* b2 = last ? nB : cB + (size_t)(t + 2) * kstep;
            const char* a3 = a2 + kstep; const char* b3 = b2 + kstep;
            PG8_LDB(B0, 0, 0); PG8_SCHED; PG8_LDA(At, 0, 0); PG8_STAGE(PG8_SA(1, 1), a1 + hstep, voffA);
            PG8_WAIT_L(8); PG8_BAR; PG8_WAIT_L(0); PG8_MMA(0, 0, At, B0); PG8_BAR; PG8_SCHED;
            PG8_LDB(B1, 0, 1); PG8_STAGE(PG8_SB(0, 0), b2, voffB);
            PG8_BAR; PG8_WAIT_L(0); PG8_MMA(0, 1, At, B1); PG8_BAR;
            PG8_LDA(At, 0, 1); PG8_STAGE(PG8_SA(0, 0), a2, voffA);
            PG8_BAR; PG8_WAIT_L(0); PG8_MMA(1, 0, At, B0); PG8_BAR; PG8_SCHED;
            PG8_STAGE(PG8_SB(0, 1), b2 + hstep, voffB);
            PG8_WAIT_V(6); PG8_BAR; PG8_MMA(1, 1, At, B1); PG8_BAR;
            PG8_LDB(B0, 1, 0); PG8_SCHED; PG8_LDA(At, 1, 0); PG8_STAGE(PG8_SA(0, 1), a2 + hstep, voffA);
            PG8_WAIT_L(8); PG8_BAR; PG8_WAIT_L(0); PG8_MMA(0, 0, At, B0); PG8_BAR; PG8_SCHED;
            PG8_LDB(B1, 1, 1); PG8_STAGE(PG8_SB(1, 0), b3, voffB);
            PG8_BAR; PG8_WAIT_L(0); PG8_MMA(0, 1, At, B1); PG8_BAR;
            PG8_LDA(At, 1, 1); PG8_STAGE(PG8_SA(1, 0), a3, voffA);
            PG8_BAR; PG8_WAIT_L(0); PG8_MMA(1, 0, At, B0); PG8_BAR; PG8_SCHED;
            PG8_STAGE(PG8_SB(1, 1), b3 + hstep, voffB);
            PG8_WAIT_V(6); PG8_BAR; PG8_MMA(1, 1, At, B1); PG8_BAR;
        }
        E(acc, cur, wr, wc, fr, fq);
        if (!has_next) break;
#pragma unroll
        for (int a = 0; a < 2; ++a)
#pragma unroll
            for (int b = 0; b < 2; ++b)
#pragma unroll
                for (int m = 0; m < 4; ++m)
#pragma unroll
                    for (int n = 0; n < 2; ++n) acc[a][b][m][n] = (f32x4){0.f, 0.f, 0.f, 0.f};
        cur = nxt; cA = nA; cB = nB; ++ui;
    }
    PG8_WAIT_V(0);
    if (wr == 0) PG8_BAR;
    PG8_BAR;
#undef PG8_SA
#undef PG8_SB
#undef PG8_STAGE
#undef PG8_LDA
#undef PG8_LDB
#undef PG8_MMA
#undef PG8_WAIT_V
#undef PG8_WAIT_L
#undef PG8_BAR
#undef PG8_SCHED
}
}
using pg8::Unit;
typedef f32x4 Acc[2][2][4][2];

struct EpiSwiGLU {
    bf16_t* act;
    __device__ __forceinline__ void operator()(const Acc& acc, const Unit& u, int wr, int wc, int fr, int fq) const {
#pragma unroll
        for (int ai = 0; ai < 2; ++ai)
#pragma unroll
            for (int m = 0; m < 4; ++m) {
                const int row = u.pm * 256 + ai * 128 + wr * 64 + m * 16 + fr;
                bf16_t* rp = act + (size_t)row * DFF + u.pn * 128 + wc * 32 + 4 * fq;
#pragma unroll
                for (int n = 0; n < 2; ++n) {
                    const f32x4 g = acc[ai][0][m][n], up = acc[ai][1][m][n];
                    u32x2 o; o[0] = pk2(silu_f(g[0]) * up[0], silu_f(g[1]) * up[1]); o[1] = pk2(silu_f(g[2]) * up[2], silu_f(g[3]) * up[3]);
                    *(u32x2*)(rp + 16 * n) = o;
                }
            }
    }
};
struct EpiResid {
    CParams* p; int l, gi; float gs;
    __device__ __forceinline__ void operator()(const Acc& acc, const Unit& u, int wr, int wc, int fr, int fq) const {
        const int cond = cond_of_row(u.pm * 256);
        f32x4 gt[2][2];
#pragma unroll
        for (int bj = 0; bj < 2; ++bj)
#pragma unroll
            for (int n = 0; n < 2; ++n) gt[bj][n] = mod4(*p, l, cond, gi, u.pn * 256 + bj * 128 + wc * 32 + 16 * n + 4 * fq) * gs;
#pragma unroll
        for (int ai = 0; ai < 2; ++ai)
#pragma unroll
            for (int m = 0; m < 4; ++m) {
                const int row = u.pm * 256 + ai * 128 + wr * 64 + m * 16 + fr;
                float* rp = p->xres + (size_t)row * DM + u.pn * 256 + wc * 32 + 4 * fq;
#pragma unroll
                for (int bj = 0; bj < 2; ++bj)
#pragma unroll
                    for (int n = 0; n < 2; ++n) { f32x4* q = (f32x4*)(rp + bj * 128 + 16 * n); *q = *q + gt[bj][n] * acc[ai][bj][m][n]; }
            }
    }
};
__device__ __forceinline__ void rope4(f32x4& x1, f32x4& x2, float pos, int i0, float expo_scale) {
#pragma unroll
    for (int j = 0; j < 4; ++j) {
        const float inv = __builtin_amdgcn_exp2f(-LOG2_ROPE * expo_scale * (float)(i0 + j));
        const float ang = pos * inv, cs = __cosf(ang), sn = __sinf(ang);
        const float a = x1[j], b = x2[j];
        x1[j] = a * cs - b * sn; x2[j] = a * sn + b * cs;
    }
}
__device__ __forceinline__ void st4bf(bf16_t* dst, const f32x4& v) { u32x2 o; o[0] = pk2(v[0], v[1]); o[1] = pk2(v[2], v[3]); *(u32x2*)dst = o; }
struct EpiAB {
    CParams* p;
    __device__ __forceinline__ void operator()(const Acc& acc, const Unit& u, int wr, int wc, int fr, int fq) const {
        CParams& P = *p;
#pragma unroll
        for (int bj = 0; bj < 2; ++bj) {
            const int cb = u.pn * 256 + bj * 128;
#pragma unroll
            for (int ai = 0; ai < 2; ++ai)
#pragma unroll
                for (int m = 0; m < 4; ++m) {
                    const int row = u.pm * 256 + ai * 128 + wr * 64 + m * 16 + fr;
                    f32x4 v0 = acc[ai][bj][m][0], v1 = acc[ai][bj][m][1];
                    const bool lat = row >= 4096;
                    const int b = row >> 8, pos = row & 255, ts = row - 4096, bs = ts >> 11, tt = ts & 2047;
                    if (cb < 3072) {
                        const int which = cb >> 10, hh = (cb & 1023) >> 7, d0 = wc * 32 + 4 * fq;
                        if (which < 2 && lat) rope4(v0, v1, (wc & 1) ? (float)(tt & 63) : (float)(tt >> 6), 4 * fq, 1.0f / 16.0f);
                        if (which == 0) {
                            v0 = v0 * (0.125f * LOG2E); v1 = v1 * (0.125f * LOG2E);
                            bf16_t* q = lat ? P.qa_s + ((size_t)(bs * 8 + hh) * 2048 + tt) * 128 : P.qa_p + ((size_t)(b * 8 + hh) * 256 + pos) * 128;
                            st4bf(q + d0, v0); st4bf(q + d0 + 16, v1);
                        } else if (which == 1) {
                            bf16_t* q = lat ? P.ka_s + ((size_t)(bs * 8 + hh) * 2560 + 512 + tt) * 128 : P.ka_p + ((size_t)(b * 8 + hh) * 256 + pos) * 128;
                            st4bf(q + d0, v0); st4bf(q + d0 + 16, v1);
                            if (!lat) { float* o = P.new_a_k + ((size_t)(b * 8 + hh) * 256 + pos) * 128 + d0; *(f32x4*)o = v0; *(f32x4*)(o + 16) = v1; }
                        } else {
                            bf16_t* q; int ld;
                            if (lat) { q = P.vta_s + (size_t)(bs * 8 + hh) * 128 * 2560 + 512 + tt; ld = 2560; } else { q = P.vta_p + (size_t)(b * 8 + hh) * 128 * 256 + pos; ld = 256; }
#pragma unroll
                            for (int j = 0; j < 4; ++j) { q[(size_t)(d0 + j) * ld] = (bf16_t)f2bf(v0[j]); q[(size_t)(d0 + 16 + j) * ld] = (bf16_t)f2bf(v1[j]); }
                            if (!lat) { float* o = P.new_a_v + ((size_t)(b * 8 + hh) * 256 + pos) * 128 + d0; *(f32x4*)o = v0; *(f32x4*)(o + 16) = v1; }
                        }
                    } else if (cb < 6144) {
                        const int c0 = cb - 3072 + wc * 32 + 4 * fq;
                        if (cb < 3584) { v0 = v0 * 0.08838834764831845f; v1 = v1 * 0.08838834764831845f; }
                        if (cb >= 4096 && cb < 5120) {
                            bf16_t* q = P.bvt + (size_t)(c0 - 1024) * NTOK + row;
#pragma unroll
                            for (int j = 0; j < 4; ++j) { q[(size_t)j * NTOK] = (bf16_t)f2bf(v0[j]); q[(size_t)(16 + j) * NTOK] = (bf16_t)f2bf(v1[j]); }
                        } else {
                            if (cb >= 5120) {
#pragma unroll
                                for (int j = 0; j < 4; ++j) { v0[j] = silu_f(v0[j]); v1[j] = silu_f(v1[j]); }
                            }
                            bf16_t* q = P.pb + (size_t)row * 3072 + c0;
                            st4bf(q, v0); st4bf(q + 16, v1);
                        }
                    } else {
                        const int c0 = cb - 6144 + wc * 32 + 4 * fq;
                        const f32x4 b0 = *(const f32x4*)(P.alpha_b + c0), b1 = *(const f32x4*)(P.alpha_b + c0 + 16);
#pragma unroll
                        for (int j = 0; j < 4; ++j) {
                            float x = v0[j] + b0[j]; v0[j] = (fminf(x, 0.f) - __logf(1.0f + __expf(-fabsf(x)))) * (1.0f / 16.0f);
                            x = v1[j] + b1[j];       v1[j] = (fminf(x, 0.f) - __logf(1.0f + __expf(-fabsf(x)))) * (1.0f / 16.0f);
                        }
                        float* q = P.la + (size_t)row * 1024 + c0;
                        *(f32x4*)q = v0; *(f32x4*)(q + 16) = v1;
                    }
                }
        }
    }
};
struct EpiC {
    CParams* p;
    __device__ __forceinline__ void operator()(const Acc& acc, const Unit& u, int wr, int wc, int fr, int fq) const {
        CParams& P = *p;
#pragma unroll
        for (int bj = 0; bj < 2; ++bj) {
            const int cb = u.pn * 256 + bj * 128;
#pragma unroll
            for (int ai = 0; ai < 2; ++ai)
#pragma unroll
                for (int m = 0; m < 4; ++m) {
                    const int row = u.pm * 256 + ai * 128 + wr * 64 + m * 16 + fr;
                    f32x4 v0 = acc[ai][bj][m][0], v1 = acc[ai][bj][m][1];
                    const bool lat = row >= 4096;
                    const int b = row >> 8, pos = row & 255, ts = row - 4096, bs = ts >> 11, tt = ts & 2047;
                    if (cb < 2560) {
                        const int gidx = wc >> 1, i0 = 16 * (wc & 1) + 4 * fq, d1 = 64 * gidx + i0;
                        if (lat) rope4(v0, v1, gidx ? (float)(tt & 63) : (float)(tt >> 6), i0, 1.0f / 32.0f);
                        if (cb < 2048) {
                            const int hh = cb >> 7;
                            v0 = v0 * (0.08838834764831845f * LOG2E); v1 = v1 * (0.08838834764831845f * LOG2E);
                            bf16_t* q = lat ? P.qc_s + ((size_t)(bs * 16 + hh) * 2048 + tt) * 128 : P.qc_p + ((size_t)(b * 16 + hh) * 256 + pos) * 128;
                            st4bf(q + d1, v0); st4bf(q + d1 + 32, v1);
                        } else {
                            const int kv = (cb - 2048) >> 7;
                            bf16_t* q = lat ? P.kc_s + ((size_t)(bs * 4 + kv) * 2560 + 512 + tt) * 128 : P.kc_p + ((size_t)(b * 4 + kv) * 256 + pos) * 128;
                            st4bf(q + d1, v0); st4bf(q + d1 + 32, v1);
                            if (!lat) { float* o = P.new_c_k + ((size_t)(b * 4 + kv) * 256 + pos) * 128 + d1; *(f32x4*)o = v0; *(f32x4*)(o + 32) = v1; }
                        }
                    } else {
                        const int kv = (cb - 2560) >> 7, d0 = wc * 32 + 4 * fq;
                        bf16_t* q; int ld;
                        if (lat) { q = P.vtc_s + (size_t)(bs * 4 + kv) * 128 * 2560 + 512 + tt; ld = 2560; } else { q = P.vtc_p + (size_t)(b * 4 + kv) * 128 * 256 + pos; ld = 256; }
#pragma unroll
                        for (int j = 0; j < 4; ++j) { q[(size_t)(d0 + j) * ld] = (bf16_t)f2bf(v0[j]); q[(size_t)(d0 + 16 + j) * ld] = (bf16_t)f2bf(v1[j]); }
                        if (!lat) { float* o = P.new_c_v + ((size_t)(b * 4 + kv) * 256 + pos) * 128 + d0; *(f32x4*)o = v0; *(f32x4*)(o + 16) = v1; }
                    }
                }
        }
    }
};

__device__ __forceinline__ int colmap(int map, int n) {
    if (map == 1) { const int t = n >> 8, w = n & 255; return (w < 128) ? t * 128 + w : DFF + t * 128 + (w - 128); }
    if (map == 2) { if (n >= 2560) return n; const int p = n & 63, i = (p >> 5) * 16 + (p & 15), s = (p >> 4) & 1; return (n & ~63) + i + 32 * s; }
    return n;
}
template <class JobT>
__device__ __forceinline__ void transpose_tile(const JobT& J, int tl) {
    const int tid = threadIdx.x, wave = tid >> 6, lane = tid & 63;
    const int nkt = J.K >> 7, nnt = J.N >> 7;
    const int kt = tl % nkt, r = tl / nkt, nt = r % nnt, b = r / nnt;
    const float* src = J.src + (size_t)b * J.sbs; bf16_t* dst = J.dst + (size_t)b * J.dbs;
    const int nsub = wave & 3, ksub = wave >> 2, kg = lane >> 3, c4 = lane & 7;
    const int n = nt * 128 + nsub * 32 + c4 * 4, k = kt * 128 + ksub * 64 + kg * 8;
    const int sc = colmap(J.map, n);
    f32x4 v[8];
#pragma unroll
    for (int i = 0; i < 8; ++i) v[i] = *(const f32x4*)(src + (size_t)(k + i) * J.lds + sc);
#pragma unroll
    for (int e = 0; e < 4; ++e) {
        u32x4 o; o[0] = pk2(v[0][e], v[1][e]); o[1] = pk2(v[2][e], v[3][e]); o[2] = pk2(v[4][e], v[5][e]); o[3] = pk2(v[6][e], v[7][e]);
        *(u32x4*)(dst + (size_t)(n + e) * J.ldd + k) = o;
    }
}
constexpr int IT_ADA = 288, IT_XCP = 1024, IT_CK = 384, IT_WEFF = 128;
__device__ __forceinline__ void phase_prep(CParams& P, LAS unsigned char* lds) {
    const int tid = threadIdx.x, wave = tid >> 6, lane = tid & 63;
    const int total = IT_ADA + IT_XCP + IT_CK + IT_WEFF + P.n_ttiles;
    LAS float* sc = (LAS float*)lds;
    LAS float* red = (LAS float*)(lds + 12288);
    for (int it = blockIdx.x; it < total; it += gridDim.x) {
        if (it < IT_ADA) {
            const int l = it / 144, r = it % 144, strip = r >> 1, kh = r & 1;
            for (int i = tid; i < 3072; i += 512) { const int c = i >> 10, k = kh * 1024 + (i & 1023); const float x = (c == 0) ? P.c_ctx[k] : P.c[(c - 1) * DM + k]; sc[i] = silu_f(x); }
            __syncthreads();
            const int kl0 = wave * 128;
            const float* W = P.ada_w + ((size_t)l * DM + kh * 1024 + kl0) * NMODW + strip * 256 + lane * 4;
            f32x4 a0 = {0, 0, 0, 0}, a1 = a0, a2 = a0;
#pragma unroll 8
            for (int k = 0; k < 128; ++k) {
                const f32x4 w = *(const f32x4*)(W + (size_t)k * NMODW);
                a0 += w * sc[kl0 + k]; a1 += w * sc[1024 + kl0 + k]; a2 += w * sc[2048 + kl0 + k];
            }
            *(LAS f32x4*)(red + (wave * 3 + 0) * 256 + lane * 4) = a0; *(LAS f32x4*)(red + (wave * 3 + 1) * 256 + lane * 4) = a1; *(LAS f32x4*)(red + (wave * 3 + 2) * 256 + lane * 4) = a2;
            __syncthreads();
            if (tid < 256) {
                const int col = strip * 256 + tid;
                const float bias = kh == 0 ? P.ada_b[(size_t)l * NMODW + col] : 0.f;
#pragma unroll
                for (int c = 0; c < 3; ++c) { float s = bias; for (int w = 0; w < 8; ++w) s += red[(w * 3 + c) * 256 + tid]; ((float*)modp(P, kh, l, c))[col] = s; }
            }
            __syncthreads();
        } else if (it < IT_ADA + IT_XCP) {
            const int j = it - IT_ADA;
#pragma unroll
            for (int i = 0; i < 8; ++i) {
                const size_t e = (size_t)j * 16384 + (size_t)(i * 512 + tid) * 4;
                const float* s = e < (size_t)4096 * DM ? P.x_prompt + e : P.x_sample + (e - (size_t)4096 * DM);
                *(f32x4*)(P.xres + e) = *(const f32x4*)s;
            }
        } else if (it < IT_ADA + IT_XCP + IT_CK) {
            const int j = it - IT_ADA - IT_XCP;
            const bool isa = j < 256; const int jj = isa ? j : j - 256;
            const float* s = isa ? P.cache_a_k : P.cache_c_k; bf16_t* d = isa ? P.ka_s : P.kc_s;
            const size_t e = (size_t)jj * 4096 + (size_t)tid * 8;
            const size_t bh = e >> 16, rem = e & 65535;
            const f32x4 v0 = *(const f32x4*)(s + e), v1 = *(const f32x4*)(s + e + 4);
            u32x4 o; o[0] = pk2(v0[0], v0[1]); o[1] = pk2(v0[2], v0[3]); o[2] = pk2(v1[0], v1[1]); o[3] = pk2(v1[2], v1[3]);
            *(u32x4*)(d + bh * (size_t)(2560 * 128) + rem) = o;
        } else if (it < IT_ADA + IT_XCP + IT_CK + IT_WEFF) {
            const int j = it - IT_ADA - IT_XCP - IT_CK;
            const int dir = (j * 8) >> 9;
            for (int kk = 0; kk < 4; ++kk) {
                const int k = tid + 512 * kk;
                float wl[16];
#pragma unroll
                for (int q = 0; q < 4; ++q) { const f32x4 t = *(const f32x4*)(P.ab_w_in + (size_t)k * 6176 + 6144 + 16 * dir + 4 * q); wl[4 * q] = t[0]; wl[4 * q + 1] = t[1]; wl[4 * q + 2] = t[2]; wl[4 * q + 3] = t[3]; }
#pragma unroll
                for (int jj = 0; jj < 8; ++jj) {
                    const int n = (j * 8 + jj) & 511; float s = 0.f;
#pragma unroll
                    for (int r = 0; r < 16; ++r) s += wl[r] * P.alpha_w[(size_t)(dir * 16 + r) * 512 + n];
                    P.wt_ab[(size_t)(6144 + j * 8 + jj) * DM + k] = (bf16_t)f2bf(s);
                }
            }
        } else {
            const int tl = it - (IT_ADA + IT_XCP + IT_CK + IT_WEFF);
            int ji = 0;
            for (int q = 1; q < 14; ++q) if (tl >= P.jobs[q].tile0) ji = q;
            transpose_tile(P.jobs[ji], tl - P.jobs[ji].tile0);
        }
    }
}

__device__ __forceinline__ void phase_norm(CParams& P, int l, int which, int si) {
    const int tid = threadIdx.x, wave = tid >> 6, lane = tid & 63;
    const float* g = P.norm_g + (size_t)(l * 3 + which) * DM;
    for (int row = blockIdx.x * 8 + wave; row < NTOK; row += gridDim.x * 8) {
        const float* xp = P.xres + (size_t)row * DM;
        const int cond = cond_of_row(row);
        f32x4 v[8]; float ss = 0.f;
#pragma unroll
        for (int i = 0; i < 8; ++i) { v[i] = *(const f32x4*)(xp + 4 * lane + 256 * i); ss += v[i][0] * v[i][0] + v[i][1] * v[i][1] + v[i][2] * v[i][2] + v[i][3] * v[i][3]; }
#pragma unroll
        for (int o = 32; o >= 1; o >>= 1) ss += __shfl_xor(ss, o, 64);
        const float rstd = rsqrtf(ss * (1.0f / DM) + 1e-6f);
#pragma unroll
        for (int i = 0; i < 8; ++i) {
            const int col = 4 * lane + 256 * i;
            const f32x4 gg = *(const f32x4*)(g + col), sh = mod4(P, l, cond, si, col), scl = mod4(P, l, cond, si + 1, col);
            const f32x4 y = (v[i] * rstd) * gg * (scl + 1.0f) + sh;
            st4bf(P.h + (size_t)row * DM + col, y);
        }
    }
}
__device__ __forceinline__ void phase_final_norm(CParams& P) {
    const int tid = threadIdx.x, wave = tid >> 6, lane = tid & 63;
    for (int row = blockIdx.x * 8 + wave; row < NTOK; row += gridDim.x * 8) {
        const float* xp = P.xres + (size_t)row * DM;
        f32x4 v[8]; float ss = 0.f;
#pragma unroll
        for (int i = 0; i < 8; ++i) { v[i] = *(const f32x4*)(xp + 4 * lane + 256 * i); ss += v[i][0] * v[i][0] + v[i][1] * v[i][1] + v[i][2] * v[i][2] + v[i][3] * v[i][3]; }
#pragma unroll
        for (int o = 32; o >= 1; o >>= 1) ss += __shfl_xor(ss, o, 64);
        const float rstd = rsqrtf(ss * (1.0f / DM) + 1e-6f);
#pragma unroll
        for (int i = 0; i < 8; ++i) { const int col = 4 * lane + 256 * i; *(f32x4*)(P.y + (size_t)row * DM + col) = (v[i] * rstd) * *(const f32x4*)(P.final_g + col); }
    }
}
__device__ __forceinline__ void phase_gla_merge(CParams& P) {
    const int tid = threadIdx.x, wave = tid >> 6, lane = tid & 63;
    for (int it = blockIdx.x * 8 + wave; it < NTOK * 4; it += gridDim.x * 8) {
        const int row = it >> 2, hh = it & 3, col = hh * 256 + 4 * lane;
        const f32x4 a = *(const f32x4*)(P.of + (size_t)row * 1024 + col) + *(const f32x4*)(P.ob + (size_t)row * 1024 + col);
        float ss = a[0] * a[0] + a[1] * a[1] + a[2] * a[2] + a[3] * a[3];
#pragma unroll
        for (int o = 32; o >= 1; o >>= 1) ss += __shfl_xor(ss, o, 64);
        const float rstd = rsqrtf(ss * (1.0f / 256.0f) + 1e-6f);
        const f32x4 g = *(const f32x4*)(P.b_norm_g + 4 * lane);
        const u32x2 br = *(const u32x2*)(P.pb + (size_t)row * 3072 + 2048 + col);
        f32x4 r; r[0] = __uint_as_float(br[0] << 16); r[1] = __uint_as_float(br[0] & 0xffff0000u); r[2] = __uint_as_float(br[1] << 16); r[3] = __uint_as_float(br[1] & 0xffff0000u);
        st4bf(P.mo + (size_t)row * DM + 1024 + col, a * rstd * g * r);
    }
}

constexpr int KS_BYTES = 64 * 136 * 2, VS_BYTES = 128 * 72 * 2, VS_OFF = 2 * KS_BYTES;
template <int DQ>
__device__ __forceinline__ void attn_pass(LAS unsigned char* lds, const bf16_t* Qw, int ldq, const bf16_t* Kb, int ldk, const bf16_t* Vt, int ldv,
                                          int nt, int t_band0, int kidx_band0, int kp_band0, int qpos, int qw0,
                                          float m0, float l0, f32x16 (&o)[4], float& l_out) {
    const int tid = threadIdx.x, lane = tid & 63, h = lane >> 5, r31 = lane & 31;
    constexpr int KROW = DQ + 8, KCH = DQ / 8, NKC = (64 * KCH) / 512;
    bf16x8 qf[DQ / 16];
#pragma unroll
    for (int ks = 0; ks < DQ / 16; ++ks) qf[ks] = *(const bf16x8*)(Qw + (size_t)r31 * ldq + 16 * ks + 8 * h);
#pragma unroll
    for (int dt = 0; dt < 4; ++dt)
#pragma unroll
        for (int i = 0; i < 16; ++i) o[dt][i] = 0.f;
    float m = m0, l = l0;
    u32x4 kreg[NKC], vreg[2];
    auto kidx_of = [&](int t) { return t < t_band0 ? 64 * t : kidx_band0 + 64 * (t - t_band0); };
    auto load_regs = [&](int t) {
        const int k0 = kidx_of(t);
#pragma unroll
        for (int i = 0; i < NKC; ++i) { const int c = tid + 512 * i, key = c / KCH, ch = c % KCH; kreg[i] = *(const u32x4*)(Kb + (size_t)(k0 + key) * ldk + 8 * ch); }
#pragma unroll
        for (int i = 0; i < 2; ++i) { const int c = tid + 512 * i, d = c >> 3, ch = c & 7; vreg[i] = *(const u32x4*)(Vt + (size_t)d * ldv + k0 + 8 * ch); }
    };
    auto store_lds = [&](int buf) {
#pragma unroll
        for (int i = 0; i < NKC; ++i) { const int c = tid + 512 * i, key = c / KCH, ch = c % KCH; *(LAS u32x4*)(lds + buf * KS_BYTES + (key * KROW + 8 * ch) * 2) = kreg[i]; }
#pragma unroll
        for (int i = 0; i < 2; ++i) { const int c = tid + 512 * i, d = c >> 3, ch = c & 7; *(LAS u32x4*)(lds + VS_OFF + buf * VS_BYTES + (d * 72 + 8 * ch) * 2) = vreg[i]; }
    };
    __syncthreads();
    load_regs(0); store_lds(0);
    __syncthreads();
    for (int t = 0; t < nt; ++t) {
        const int buf = t & 1;
        if (t + 1 < nt) load_regs(t + 1);
        const bool band = t >= t_band0;
        const int kp0 = kp_band0 + 64 * (t - t_band0);
        const bool skip = band && (kp0 > qw0 + 31 + 128 || kp0 + 63 < qw0 - 128);
        if (!skip) {
            f32x16 s[2];
#pragma unroll
            for (int kt = 0; kt < 2; ++kt) {
#pragma unroll
                for (int i = 0; i < 16; ++i) s[kt][i] = 0.f;
#pragma unroll
                for (int ks = 0; ks < DQ / 16; ++ks) {
                    const bf16x8 a = *(const LAS bf16x8*)(lds + buf * KS_BYTES + ((kt * 32 + r31) * KROW + 16 * ks + 8 * h) * 2);
                    s[kt] = mfma32(a, qf[ks], s[kt]);
                }
            }
            if (band) {
#pragma unroll
                for (int kt = 0; kt < 2; ++kt)
#pragma unroll
                    for (int i = 0; i < 16; ++i) { const int kp = kp0 + 32 * kt + (i & 3) + 8 * (i >> 2) + 4 * h; const int dlt = qpos - kp; if (dlt > 128 || dlt < -128) s[kt][i] = -1e30f; }
            }
            float mx = s[0][0];
#pragma unroll
            for (int kt = 0; kt < 2; ++kt)
#pragma unroll
                for (int i = 0; i < 16; ++i) mx = fmaxf(mx, s[kt][i]);
            mx = fmaxf(mx, xor32(mx));
            const float mn = fmaxf(m, mx), alpha = __builtin_amdgcn_exp2f(m - mn);
            m = mn;
            float ps = 0.f;
#pragma unroll
            for (int kt = 0; kt < 2; ++kt)
#pragma unroll
                for (int i = 0; i < 16; ++i) { const float pv = __builtin_amdgcn_exp2f(s[kt][i] - mn); s[kt][i] = pv; ps += pv; }
            l = l * alpha + ps;
#pragma unroll
            for (int dt = 0; dt < 4; ++dt)
#pragma unroll
                for (int i = 0; i < 16; ++i) o[dt][i] *= alpha;
            bf16x8 pb[2][2];
#pragma unroll
            for (int kt = 0; kt < 2; ++kt) { pb[kt][0] = pack8(s[kt], 0); pb[kt][1] = pack8(s[kt], 8); }
#pragma unroll
            for (int dt = 0; dt < 4; ++dt)
#pragma unroll
                for (int kt = 0; kt < 2; ++kt)
#pragma unroll
                    for (int s2 = 0; s2 < 2; ++s2) {
                        const LAS unsigned char* vp = lds + VS_OFF + buf * VS_BYTES + ((dt * 32 + r31) * 72 + 32 * kt + 16 * s2 + 4 * h) * 2;
                        const u32x2 lo = *(const LAS u32x2*)vp, hi = *(const LAS u32x2*)(vp + 16);
                        u32x4 av; av[0] = lo[0]; av[1] = lo[1]; av[2] = hi[0]; av[3] = hi[1];
                        o[dt] = mfma32(__builtin_bit_cast(bf16x8, av), pb[kt][s2], o[dt]);
                    }
        }
        if (t + 1 < nt) store_lds(buf ^ 1);
        __syncthreads();
    }
    l_out = l + xor32(l);
}

__device__ __forceinline__ void diff_attn_item(CParams& P, LAS unsigned char* lds, int item, float lam, float lam_init) {
    const int tid = threadIdx.x, wave = tid >> 6, lane = tid & 63, h = lane >> 5, r31 = lane & 31;
    const bf16_t *Q, *K, *Vt; int nk, row0;
    if (item < 128) { const int bh = item >> 3, qt = item & 7; Q = P.qa_s + ((size_t)bh * 2048 + qt * 256) * 128; K = P.ka_s + (size_t)bh * 2560 * 128; Vt = P.vta_s + (size_t)bh * 128 * 2560; nk = 2560; row0 = 4096 + (bh >> 3) * 2048 + qt * 256; }
    else { const int bh = item - 128; Q = P.qa_p + (size_t)bh * 256 * 128; K = P.ka_p + (size_t)bh * 256 * 128; Vt = P.vta_p + (size_t)bh * 128 * 256; nk = 256; row0 = (bh >> 3) * 256; }
    const int hh = (item < 128 ? (item >> 3) : (item - 128)) & 7;
    f32x16 o1[4]; float l1, l2;
    f32x4* park = (f32x4*)P.park + (size_t)blockIdx.x * 16 * 512 + tid;
    attn_pass<64>(lds, Q + (size_t)(wave * 32) * 128, 128, K, 128, Vt, nk, nk / 64, nk / 64, 0, 0, 0, 0, -1e30f, 0.f, o1, l1);
    {
        const float i1 = 1.0f / l1;
#pragma unroll
        for (int dt = 0; dt < 4; ++dt)
#pragma unroll
            for (int g = 0; g < 4; ++g) { f32x4 v; v[0] = o1[dt][4 * g] * i1; v[1] = o1[dt][4 * g + 1] * i1; v[2] = o1[dt][4 * g + 2] * i1; v[3] = o1[dt][4 * g + 3] * i1; park[(dt * 4 + g) * 512] = v; }
    }
    attn_pass<64>(lds, Q + (size_t)(wave * 32) * 128 + 64, 128, K + 64, 128, Vt, nk, nk / 64, nk / 64, 0, 0, 0, 0, -1e30f, 0.f, o1, l2);
    const float i2 = lam / l2;
    float ss = 0.f;
#pragma unroll
    for (int dt = 0; dt < 4; ++dt)
#pragma unroll
        for (int g = 0; g < 4; ++g) {
            const f32x4 v = park[(dt * 4 + g) * 512];
#pragma unroll
            for (int j = 0; j < 4; ++j) { const float a = v[j] - o1[dt][4 * g + j] * i2; o1[dt][4 * g + j] = a; ss += a * a; }
        }
    ss += xor32(ss);
    const float sc = rsqrtf(ss * (1.0f / 128.0f) + 1e-6f) * (1.0f - lam_init);
    bf16_t* dst = P.mo + (size_t)(row0 + wave * 32 + r31) * DM + hh * 128;
#pragma unroll
    for (int dt = 0; dt < 4; ++dt)
#pragma unroll
        for (int g = 0; g < 4; ++g) {
            const int d = 32 * dt + 8 * g + 4 * h;
            const f32x4 gg = *(const f32x4*)(P.a_subln_g + d);
            f32x4 v; v[0] = o1[dt][4 * g] * sc * gg[0]; v[1] = o1[dt][4 * g + 1] * sc * gg[1]; v[2] = o1[dt][4 * g + 2] * sc * gg[2]; v[3] = o1[dt][4 * g + 3] * sc * gg[3];
            st4bf(dst + d, v);
        }
}
__device__ __forceinline__ void sink_attn_item(CParams& P, LAS unsigned char* lds, int item) {
    const int tid = threadIdx.x, wave = tid >> 6, lane = tid & 63, h = lane >> 5, r31 = lane & 31;
    f32x16 o[4]; float l; int row0, hh;
    if (item < 256) {
        const int bs = item >> 7, qt = item & 7; hh = (item >> 3) & 15; const int kv = hh >> 2, q0 = qt * 256;
        const bf16_t* Q = P.qc_s + ((size_t)(bs * 16 + hh) * 2048 + q0 + wave * 32) * 128;
        const bf16_t* K = P.kc_s + (size_t)(bs * 4 + kv) * 2560 * 128; const bf16_t* Vt = P.vtc_s + (size_t)(bs * 4 + kv) * 128 * 2560;
        const int lo = q0 - 128 < 0 ? 0 : q0 - 128, hi = q0 + 384 > 2048 ? 2048 : q0 + 384;
        const float sk = P.c_sink[hh] * LOG2E;
        attn_pass<128>(lds, Q, 128, K, 128, Vt, 2560, 8 + (hi - lo) / 64, 8, 512 + lo, lo, q0 + wave * 32 + r31, q0 + wave * 32, sk, 0.5f, o, l);
        row0 = 4096 + bs * 2048 + q0;
    } else {
        const int bh = item - 256, b = bh >> 4; hh = bh & 15; const int kv = hh >> 2;
        const bf16_t* Q = P.qc_p + ((size_t)bh * 256 + wave * 32) * 128;
        const bf16_t* K = P.kc_p + (size_t)(b * 4 + kv) * 256 * 128; const bf16_t* Vt = P.vtc_p + (size_t)(b * 4 + kv) * 128 * 256;
        const float sk = P.c_sink[hh] * LOG2E;
        attn_pass<128>(lds, Q, 128, K, 128, Vt, 256, 4, 4, 0, 0, 0, 0, sk, 0.5f, o, l);
        row0 = b * 256;
    }
    const float il = 1.0f / l;
    bf16_t* dst = P.mo + (size_t)(row0 + wave * 32 + r31) * DM + hh * 128;
#pragma unroll
    for (int dt = 0; dt < 4; ++dt)
#pragma unroll
        for (int g = 0; g < 4; ++g) {
            f32x4 v; v[0] = o[dt][4 * g] * il; v[1] = o[dt][4 * g + 1] * il; v[2] = o[dt][4 * g + 2] * il; v[3] = o[dt][4 * g + 3] * il;
            st4bf(dst + 32 * dt + 8 * g + 4 * h, v);
        }
}

constexpr int G_QD = 0, G_KD = 8704, G_KDT = 17408, G_AD = 27648, G_BUF = 28160;
__device__ __forceinline__ void gla_item(CParams& P, LAS unsigned char* lds, int item) {
    const int tid = threadIdx.x, wave = tid >> 6, lane = tid & 63, h = lane >> 5, r31 = lane & 31;
    int row0, nch, hh, dir, sidx; bool lat;
    if (item < 16) { lat = true; sidx = item >> 3; hh = (item >> 1) & 3; dir = item & 1; row0 = 4096 + sidx * 2048; nch = 64; }
    else { lat = false; const int j = item - 16; sidx = j >> 3; hh = (j >> 1) & 3; dir = j & 1; row0 = sidx * 256; nch = 8; }
    const int eg = hh * 256 + wave * 32 + r31;
    f32x16 S[4];
    if (lat) {
        const float* st = (dir ? P.state_b : P.state_f) + (size_t)(sidx * 4 + hh) * 128 * 256 + wave * 32 + r31;
#pragma unroll
        for (int dt = 0; dt < 4; ++dt)
#pragma unroll
            for (int i = 0; i < 16; ++i) S[dt][i] = st[(size_t)(32 * dt + (i & 3) + 8 * (i >> 2) + 4 * h) * 256];
    } else {
#pragma unroll
        for (int dt = 0; dt < 4; ++dt)
#pragma unroll
            for (int i = 0; i < 16; ++i) S[dt][i] = 0.f;
    }
    const int pd = tid & 127, pg = tid >> 7;
    const float* LA = P.la + (size_t)dir * 512 + hh * 128 + pd;
    auto prep = [&](int c, int buf) {
        const int ch = dir ? nch - 1 - c : c, tok0 = row0 + 32 * ch;
        LAS unsigned char* B = lds + buf * G_BUF;
        float base = 0.f;
        for (int jj = 0; jj < 8 * pg; ++jj) { const int i = dir ? 31 - jj : jj; base += LA[(size_t)(tok0 + i) * 1024]; }
        float cum = base; unsigned kp[8];
#pragma unroll
        for (int jj = 0; jj < 8; ++jj) {
            const int j2 = 8 * pg + jj, i = dir ? 31 - j2 : j2;
            cum += LA[(size_t)(tok0 + i) * 1024];
            const float q = bf2f(P.pb[(size_t)(tok0 + i) * 3072 + hh * 128 + pd]), k = bf2f(P.pb[(size_t)(tok0 + i) * 3072 + 512 + hh * 128 + pd]);
            const unsigned qd = f2bf(q * __expf(cum)), kd = f2bf(k * __expf(-cum));
            *(LAS bf16_t*)(B + G_QD + (i * 136 + pd) * 2) = (bf16_t)qd;
            *(LAS bf16_t*)(B + G_KD + (i * 136 + pd) * 2) = (bf16_t)kd;
            kp[dir ? 7 - jj : jj] = kd;
        }
        const int i8 = dir ? 24 - 8 * pg : 8 * pg;
        u32x4 o; o[0] = kp[0] | (kp[1] << 16); o[1] = kp[2] | (kp[3] << 16); o[2] = kp[4] | (kp[5] << 16); o[3] = kp[6] | (kp[7] << 16);
        *(LAS u32x4*)(B + G_KDT + (pd * 40 + i8) * 2) = o;
        if (pg == 3) *(LAS float*)(B + G_AD + pd * 4) = __expf(cum);
    };
    __syncthreads();
    prep(0, 0);
    __syncthreads();
    float* OUT = dir ? P.ob : P.of;
    for (int c = 0; c < nch; ++c) {
        const int buf = c & 1;
        if (c + 1 < nch) prep(c + 1, buf ^ 1);
        const LAS unsigned char* B = lds + buf * G_BUF;
        const int ch = dir ? nch - 1 - c : c, tok0 = row0 + 32 * ch;
        f32x16 sT;
#pragma unroll
        for (int i = 0; i < 16; ++i) sT[i] = 0.f;
#pragma unroll
        for (int ks = 0; ks < 8; ++ks) {
            const bf16x8 a = *(const LAS bf16x8*)(B + G_KD + (r31 * 136 + 16 * ks + 8 * h) * 2);
            const bf16x8 b = *(const LAS bf16x8*)(B + G_QD + (r31 * 136 + 16 * ks + 8 * h) * 2);
            sT = mfma32(a, b, sT);
        }
#pragma unroll
        for (int i = 0; i < 16; ++i) { const int s = (i & 3) + 8 * (i >> 2) + 4 * h; const bool keep = dir ? (s >= r31) : (s <= r31); if (!keep) sT[i] = 0.f; }
        bf16x8 pb[2]; pb[0] = pack8(sT, 0); pb[1] = pack8(sT, 8);
        f32x16 oT;
#pragma unroll
        for (int i = 0; i < 16; ++i) oT[i] = 0.f;
#pragma unroll
        for (int dt = 0; dt < 4; ++dt)
#pragma unroll
            for (int s2 = 0; s2 < 2; ++s2) {
                const LAS unsigned char* qp = B + G_QD + (r31 * 136 + 32 * dt + 16 * s2 + 4 * h) * 2;
                const u32x2 lo = *(const LAS u32x2*)qp, hi = *(const LAS u32x2*)(qp + 16);
                u32x4 bv; bv[0] = lo[0]; bv[1] = lo[1]; bv[2] = hi[0]; bv[3] = hi[1];
                oT = mfma32(pack8(S[dt], 8 * s2), __builtin_bit_cast(bf16x8, bv), oT);
            }
        const bf16_t* vrow = P.bvt + (size_t)eg * NTOK + tok0;
#pragma unroll
        for (int s2 = 0; s2 < 2; ++s2) {
            const u32x2 lo = *(const u32x2*)(vrow + 16 * s2 + 4 * h), hi = *(const u32x2*)(vrow + 16 * s2 + 8 + 4 * h);
            u32x4 av; av[0] = lo[0]; av[1] = lo[1]; av[2] = hi[0]; av[3] = hi[1];
            oT = mfma32(__builtin_bit_cast(bf16x8, av), pb[s2], oT);
        }
        {
            float* op = OUT + (size_t)(tok0 + r31) * 1024 + hh * 256 + wave * 32 + 4 * h;
#pragma unroll
            for (int g = 0; g < 4; ++g) { f32x4 v; v[0] = oT[4 * g]; v[1] = oT[4 * g + 1]; v[2] = oT[4 * g + 2]; v[3] = oT[4 * g + 3]; *(f32x4*)(op + 8 * g) = v; }
        }
#pragma unroll
        for (int s2 = 0; s2 < 2; ++s2) {
            const bf16x8 bv = *(const bf16x8*)(vrow + 16 * s2 + 8 * h);
#pragma unroll
            for (int dt = 0; dt < 4; ++dt) {
                const bf16x8 a = *(const LAS bf16x8*)(B + G_KDT + ((32 * dt + r31) * 40 + 16 * s2 + 8 * h) * 2);
                S[dt] = mfma32(a, bv, S[dt]);
            }
        }
#pragma unroll
        for (int dt = 0; dt < 4; ++dt)
#pragma unroll
            for (int g = 0; g < 4; ++g) {
                const f32x4 ad = *(const LAS f32x4*)(B + G_AD + (32 * dt + 8 * g + 4 * h) * 4);
                S[dt][4 * g] *= ad[0]; S[dt][4 * g + 1] *= ad[1]; S[dt][4 * g + 2] *= ad[2]; S[dt][4 * g + 3] *= ad[3];
            }
        __syncthreads();
    }
    if (!lat) {
        float* st = (dir ? P.new_b_b : P.new_b_f) + (size_t)(sidx * 4 + hh) * 128 * 256 + wave * 32 + r31;
#pragma unroll
        for (int dt = 0; dt < 4; ++dt)
#pragma unroll
            for (int i = 0; i < 16; ++i) st[(size_t)(32 * dt + (i & 3) + 8 * (i >> 2) + 4 * h) * 256] = S[dt][i];
    }
}

__device__ __forceinline__ void phase_mix0(CParams& P, LAS unsigned char* lds) {
    const int NG = 32;
    if ((int)blockIdx.x < NG) {
        if (blockIdx.x < 16) gla_item(P, lds, blockIdx.x);
        else for (int j = 0; j < 8; ++j) gla_item(P, lds, 16 + (blockIdx.x - 16) * 8 + j);
    } else {
        const float* lp = P.a_lambda;
        float s1 = 0.f, s2 = 0.f;
        for (int i = 0; i < 64; ++i) { s1 += lp[i] * lp[64 + i]; s2 += lp[128 + i] * lp[192 + i]; }
        const float lam_init = 0.2f, lam = __expf(s1) - __expf(s2) + lam_init;
        for (int it = blockIdx.x - NG; it < 256; it += gridDim.x - NG) diff_attn_item(P, lds, it, lam, lam_init);
    }
}
__device__ __forceinline__ void phase_mix1(CParams& P, LAS unsigned char* lds) {
    for (int it = blockIdx.x; it < 512; it += gridDim.x) sink_attn_item(P, lds, it);
}

__global__ void __launch_bounds__(512, 2) fwd_megakernel(const Params Pk) {
    extern __shared__ __attribute__((aligned(16))) unsigned char shm[];
    LAS unsigned char* lds = (LAS unsigned char*)shm;
    cg::grid_group grid = cg::this_grid();
    CParams* kp = (CParams*)__builtin_amdgcn_kernarg_segment_ptr();
    const int phase_lo = Pk.phase_lo, phase_hi = Pk.phase_hi;
    int ph = 0;
#define PHASE(...) do { if (ph >= phase_lo && ph < phase_hi) { CParams* pp = kp; asm volatile("" : "+s"(pp)); CParams& P = *pp; __VA_ARGS__; if (ph + 1 < phase_hi) grid.sync(); } ++ph; } while (0)
#define GEMM(EpiT, epi, Aptr, Btptr, Nn, Kk) do { pg8::Gemm g{Aptr, Btptr, NTOK, Nn, Kk}; pg8::StaticOrder S; S.init(NTOK, Nn, gridDim.x, blockIdx.x); EpiT E = epi; pg8::gemm_phase<EpiT>(lds, g, S, E); } while (0)
#define LAYER_HEAD(l) \
        PHASE(phase_norm(P, l, 0, 0)); \
        PHASE(GEMM(EpiSwiGLU, (EpiSwiGLU{P.act}), P.h, P.wt_in + (size_t)(l * 2) * 2 * DFF * DM, 2 * DFF, DM)); \
        PHASE(GEMM(EpiResid, (EpiResid{&P, l, 2, 0.5f}), P.act, P.wt_out + (size_t)(l * 2) * DM * DFF, DM, DFF)); \
        PHASE(phase_norm(P, l, 1, 3));
#define LAYER_TAIL(l) \
        PHASE(phase_norm(P, l, 2, 6)); \
        PHASE(GEMM(EpiSwiGLU, (EpiSwiGLU{P.act}), P.h, P.wt_in + (size_t)(l * 2 + 1) * 2 * DFF * DM, 2 * DFF, DM)); \
        PHASE(GEMM(EpiResid, (EpiResid{&P, l, 8, 0.5f}), P.act, P.wt_out + (size_t)(l * 2 + 1) * DM * DFF, DM, DFF));
    PHASE(phase_prep(P, lds));
    LAYER_HEAD(0)
    PHASE(GEMM(EpiAB, (EpiAB{&P}), P.h, P.wt_ab, 7168, DM));
    PHASE(phase_mix0(P, lds));
    PHASE(phase_gla_merge(P));
    PHASE(GEMM(EpiResid, (EpiResid{&P, 0, 5, 1.0f}), P.mo, P.wt_abo, DM, DM));
    LAYER_TAIL(0)
    LAYER_HEAD(1)
    PHASE(GEMM(EpiC, (EpiC{&P}), P.h, P.wt_c, 3072, DM));
    PHASE(phase_mix1(P, lds));
    PHASE(GEMM(EpiResid, (EpiResid{&P, 1, 5, 1.0f}), P.mo, P.wt_co, DM, DM));
    LAYER_TAIL(1)
    PHASE(phase_final_norm(P));
}
constexpr int N_PHASES = 1 + 11 + 10 + 1;

extern "C" void kernel_launch(void* const* d_in, const int* in_sizes, int n_in, void* d_out, int out_size, void* d_ws, size_t ws_size, hipStream_t stream) {
    Params p; memset(&p, 0, sizeof(p));
    const float* const* in = (const float* const*)d_in;
    p.x_prompt = in[0]; p.x_sample = in[1]; p.cache_a_k = in[2]; p.cache_a_v = in[3]; p.state_f = in[4]; p.state_b = in[5]; p.cache_c_k = in[6]; p.cache_c_v = in[7]; p.c = in[8]; p.c_ctx = in[9];
    p.ada_w = in[10]; p.ada_b = in[11]; p.norm_g = in[12]; p.ffn_w_in = in[13]; p.ffn_w_out = in[14]; p.ab_w_in = in[15]; p.ab_w_out = in[16]; p.a_lambda = in[17]; p.a_subln_g = in[18];
    p.alpha_w = in[19]; p.alpha_b = in[20]; p.b_norm_g = in[21]; p.c_w_in = in[22]; p.c_w_out = in[23]; p.c_sink = in[24]; p.final_g = in[25];
    float* out = (float*)d_out;
    p.y = out; p.new_a_k = out + 16777216; p.new_a_v = p.new_a_k + 4194304; p.new_b_f = p.new_a_v + 4194304; p.new_b_b = p.new_b_f + 2097152; p.new_c_k = p.new_b_b + 2097152; p.new_c_v = p.new_c_k + 2097152;
    char* w = (char*)d_ws; size_t off = 0;
    auto take = [&](size_t bytes) { char* r = w + off; off += (bytes + 255) & ~(size_t)255; return r; };
    p.mods = (float*)take((size_t)2 * 2 * 3 * NMODW * 4);
    p.xres = (float*)take((size_t)NTOK * DM * 4);
    p.h = (bf16_t*)take((size_t)NTOK * DM * 2);
    p.act = (bf16_t*)take((size_t)NTOK * DFF * 2);
    p.mo = (bf16_t*)take((size_t)NTOK * DM * 2);
    p.wt_in = (bf16_t*)take((size_t)4 * 2 * DFF * DM * 2);
    p.wt_out = (bf16_t*)take((size_t)4 * DM * DFF * 2);
    p.wt_ab = (bf16_t*)take((size_t)7168 * DM * 2);
    p.wt_abo = (bf16_t*)take((size_t)DM * DM * 2);
    p.wt_c = (bf16_t*)take((size_t)3072 * DM * 2);
    p.wt_co = (bf16_t*)take((size_t)DM * DM * 2);
    p.qa_p = (bf16_t*)take((size_t)16 * 8 * 256 * 128 * 2); p.ka_p = (bf16_t*)take((size_t)16 * 8 * 256 * 128 * 2); p.vta_p = (bf16_t*)take((size_t)16 * 8 * 256 * 128 * 2);
    p.qa_s = (bf16_t*)take((size_t)2 * 8 * 2048 * 128 * 2); p.ka_s = (bf16_t*)take((size_t)2 * 8 * 2560 * 128 * 2); p.vta_s = (bf16_t*)take((size_t)2 * 8 * 2560 * 128 * 2);
    p.qc_p = (bf16_t*)take((size_t)16 * 16 * 256 * 128 * 2); p.kc_p = (bf16_t*)take((size_t)16 * 4 * 256 * 128 * 2); p.vtc_p = (bf16_t*)take((size_t)16 * 4 * 256 * 128 * 2);
    p.qc_s = (bf16_t*)take((size_t)2 * 16 * 2048 * 128 * 2); p.kc_s = (bf16_t*)take((size_t)2 * 4 * 2560 * 128 * 2); p.vtc_s = (bf16_t*)take((size_t)2 * 4 * 2560 * 128 * 2);
    p.pb = (bf16_t*)take((size_t)NTOK * 3072 * 2);
    p.bvt = (bf16_t*)take((size_t)1024 * NTOK * 2);
    p.la = (float*)take((size_t)NTOK * 1024 * 4);
    p.of = (float*)take((size_t)NTOK * 1024 * 4);
    p.ob = (float*)take((size_t)NTOK * 1024 * 4);
    p.park = (float*)take((size_t)512 * 16 * 512 * 16);
    int nj = 0, t0 = 0;
    auto job = [&](const float* src, bf16_t* dst, int lds_, int K, int N, int ldd, int map, int nb, long long sbs, long long dbs) {
        TJob& J = p.jobs[nj++]; J.src = src; J.dst = dst; J.lds = lds_; J.K = K; J.N = N; J.ldd = ldd; J.map = map; J.nbatch = nb; J.sbs = sbs; J.dbs = dbs; J.tile0 = t0; J.pad = 0;
        t0 += nb * (K / 128) * (N / 128);
    };
    for (int i = 0; i < 4; ++i) job(p.ffn_w_in + (size_t)i * DM * 2 * DFF, p.wt_in + (size_t)i * 2 * DFF * DM, 2 * DFF, DM, 2 * DFF, DM, 1, 1, 0, 0);
    for (int i = 0; i < 4; ++i) job(p.ffn_w_out + (size_t)i * DFF * DM, p.wt_out + (size_t)i * DM * DFF, DM, DFF, DM, DFF, 0, 1, 0, 0);
    job(p.ab_w_in, p.wt_ab, 6176, DM, 6144, DM, 0, 1, 0, 0);
    job(p.ab_w_out, p.wt_abo, DM, DM, DM, DM, 0, 1, 0, 0);
    job(p.c_w_in, p.wt_c, 3072, DM, 3072, DM, 2, 1, 0, 0);
    job(p.c_w_out, p.wt_co, DM, DM, DM, DM, 0, 1, 0, 0);
    job(p.cache_a_v, p.vta_s, 128, 512, 128, 2560, 0, 16, 512 * 128, 128 * 2560);
    job(p.cache_c_v, p.vtc_s, 128, 512, 128, 2560, 0, 8, 512 * 128, 128 * 2560);
    p.n_ttiles = t0;

    constexpr size_t kDynLds = pg8::STAGE_BYTES;
    static int grid_blocks = 0;
    if (!grid_blocks) {
        int dev = 0, cus = 0, per_cu = 0;
        hipGetDevice(&dev);
        hipDeviceGetAttribute(&cus, hipDeviceAttributeMultiprocessorCount, dev);
        hipFuncSetAttribute((const void*)fwd_megakernel, hipFuncAttributeMaxDynamicSharedMemorySize, (int)kDynLds);
        hipOccupancyMaxActiveBlocksPerMultiprocessor(&per_cu, fwd_megakernel, 512, kDynLds);
        if (per_cu < 1) per_cu = 1;
        grid_blocks = cus * 1;
    }
#if N_LAUNCH_SPLIT
    for (int ph = 0; ph < N_PHASES; ++ph) {
        p.phase_lo = ph; p.phase_hi = ph + 1;
        hipLaunchKernelGGL(fwd_megakernel, dim3(grid_blocks), dim3(512), kDynLds, stream, p);
    }
#else
    p.phase_lo = 0; p.phase_hi = N_PHASES;
    void* args[] = {&p};
    hipError_t e = hipLaunchCooperativeKernel((const void*)fwd_megakernel, dim3(grid_blocks), dim3(512), args, kDynLds, stream);
    if (e != hipSuccess) fprintf(stderr, "cooperative launch failed: %s (grid %d)\n", hipGetErrorString(e), grid_blocks);
#endif
}
```

```cpp
#include <hip/hip_runtime.h>
#include <hip/hip_cooperative_groups.h>
#include <stdint.h>
#include <string.h>
#include <stdio.h>
namespace cg = cooperative_groups;

typedef unsigned short bf16_t;
typedef short bf16x8 __attribute__((ext_vector_type(8)));
typedef float f32x4 __attribute__((ext_vector_type(4)));
typedef float f32x16 __attribute__((ext_vector_type(16)));
typedef unsigned u32x4 __attribute__((ext_vector_type(4)));
typedef unsigned u32x2 __attribute__((ext_vector_type(2)));
#define LAS __attribute__((address_space(3)))

#ifndef REP_PREP
#define REP_PREP 1
#endif
#ifndef REP_MIX0
#define REP_MIX0 1
#endif
#ifndef REP_MIX1
#define REP_MIX1 1
#endif
#ifndef REP_NORM
#define REP_NORM 1
#endif
#ifndef REP_FFNIN
#define REP_FFNIN 1
#endif
#ifndef REP_SYNC
#define REP_SYNC 1
#endif
#ifndef N_LAUNCH_SPLIT
#define N_LAUNCH_SPLIT 0
#endif

constexpr int NTOK = 8192, DM = 2048, DFF = 5632, NMODW = 18432;
constexpr float LOG2E = 1.4426950408889634f;
constexpr float LOG2_ROPE = 13.287712379549449f;

struct TJob { const float* src; bf16_t* dst; long long sbs, dbs; int lds, K, N, ldd, map, nbatch, tile0, pad; };

struct Params {
    const float *x_prompt, *x_sample, *cache_a_k, *cache_a_v, *state_f, *state_b, *cache_c_k, *cache_c_v, *c, *c_ctx;
    const float *ada_w, *ada_b, *norm_g, *ffn_w_in, *ffn_w_out, *ab_w_in, *ab_w_out, *a_lambda, *a_subln_g, *alpha_w, *alpha_b, *b_norm_g;
    const float *c_w_in, *c_w_out, *c_sink, *final_g;
    float *y, *new_a_k, *new_a_v, *new_b_f, *new_b_b, *new_c_k, *new_c_v;
    float* mods;
    float* xres;
    bf16_t* h;
    bf16_t* act;
    bf16_t* mo;
    bf16_t* wt_in;
    bf16_t* wt_out;
    bf16_t* wt_ab;
    bf16_t* wt_abo;
    bf16_t* wt_c;
    bf16_t* wt_co;
    bf16_t *qa_p, *ka_p, *vta_p;
    bf16_t *qa_s, *ka_s, *vta_s;
    bf16_t *qc_p, *kc_p, *vtc_p;
    bf16_t *qc_s, *kc_s, *vtc_s;
    bf16_t* pb;
    bf16_t* bvt;
    float* la;
    float* lacum;
    float *of, *ob;
    float* park;
    TJob jobs[14];
    int n_ttiles, phase_lo, phase_hi, pad0;
};

typedef const __attribute__((address_space(4))) Params CParams;

__device__ __forceinline__ unsigned f2bf(float f) { unsigned u = __float_as_uint(f); u += 0x7FFFu + ((u >> 16) & 1u); return u >> 16; }
__device__ __forceinline__ unsigned pk2(float lo, float hi) { return f2bf(lo) | (f2bf(hi) << 16); }
__device__ __forceinline__ float bf2f(bf16_t b) { return __uint_as_float(((unsigned)b) << 16); }
__device__ __forceinline__ float silu_f(float x) { return x / (1.0f + __expf(-x)); }
__device__ __forceinline__ int cond_of_row(int row) { return row < 4096 ? 0 : 1 + ((row - 4096) >> 11); }
__device__ __forceinline__ const float* modp(CParams& p, int kh, int l, int c) { return p.mods + (size_t)((kh * 2 + l) * 3 + c) * NMODW; }
__device__ __forceinline__ f32x4 mod4(CParams& p, int l, int c, int i, int col) {
    const f32x4 a = *(const f32x4*)(modp(p, 0, l, c) + i * DM + col), b = *(const f32x4*)(modp(p, 1, l, c) + i * DM + col);
    return a + b;
}
__device__ __forceinline__ f32x16 mfma32(bf16x8 a, bf16x8 b, f32x16 c) { return __builtin_amdgcn_mfma_f32_32x32x16_bf16(a, b, c, 0, 0, 0); }
__device__ __forceinline__ bf16x8 pack8(const f32x16& s, int base) {
    u32x4 r; r[0] = pk2(s[base + 0], s[base + 1]); r[1] = pk2(s[base + 2], s[base + 3]); r[2] = pk2(s[base + 4], s[base + 5]); r[3] = pk2(s[base + 6], s[base + 7]);
    return __builtin_bit_cast(bf16x8, r);
}
__device__ __forceinline__ float xor32(float v) { return __shfl_xor(v, 32, 64); }

namespace pg8 {
constexpr int BM = 256, BK = 64, HALF = 128, HTB = HALF * BK * 2, STAGE_BYTES = 8 * HTB, NXCD = 8, WGM = 8;
__device__ __forceinline__ int lds_byte(int r, int c) { const int st = (r >> 4) * 2 + (c >> 5), rr = r & 15, cc = c & 31, ob = rr * 64 + cc * 2; return st * 1024 + (ob ^ (((ob >> 9) & 1) << 5)); }
__device__ __forceinline__ void stage_rc(int b, int& R, int& C) { const int st = b / 1024, sb = b % 1024, swz = sb ^ (((sb >> 9) & 1) << 5); R = (st >> 1) * 16 + swz / 64; C = (st & 1) * 32 + (swz % 64) / 2; }
struct Unit { int pm, pn; };
struct Gemm { const bf16_t* A; const bf16_t* Bt; int M, N, K; };
struct StaticOrder {
    int nM, nN, nwg, G, c;
    __device__ void init(int M, int N, int G_, int c_) { nM = M / BM; nN = N / BM; nwg = nM * nN; G = G_; c = c_; }
    __device__ bool next(int i, Unit& u) const {
        const long L = (long)i * G + c; if (L >= nwg) return false;
        int wgid = (int)L; { const int q = nwg / NXCD, r = nwg % NXCD, xcd = wgid % NXCD, off = wgid / NXCD; wgid = (xcd < r ? xcd * (q + 1) : r * (q + 1) + (xcd - r) * q) + off; }
        const int nig = WGM * nN, gid = wgid / nig, fm = gid * WGM, gsz = (nM - fm) < WGM ? (nM - fm) : WGM;
        u.pm = fm + ((wgid % nig) % gsz); u.pn = (wgid % nig) / gsz; return true;
    }
};
template <class Epi>
__device__ __forceinline__ void gemm_phase(LAS unsigned char* lds, const Gemm g, const StaticOrder& S, const Epi& E) {
    const int tid = threadIdx.x, wid = __builtin_amdgcn_readfirstlane(tid >> 6), lane = tid & 63, wr = wid >> 2, wc = wid & 3, fr = lane & 15, fq = lane >> 4;
    const int K = g.K, nt = K / BK;
    unsigned voffA[2], voffB[2];
#pragma unroll
    for (int i = 0; i < 2; ++i) { int R, C; stage_rc(tid * 16 + i * 8192, R, C); voffA[i] = (unsigned)(R * K + C) * 2u; voffB[i] = voffA[i]; }
    const size_t kstep = (size_t)(BK * 2);
    const size_t hstep = (size_t)HALF * K * 2;
    const size_t tstep = 2 * hstep;
    const unsigned ldsw = (unsigned)wid * 1024u;
    const int aoff = lds_byte(wr * 64 + fr, fq * 8), boff = lds_byte(wc * 32 + fr, fq * 8);
#define PG8_SA(b, h) (((b) * 2 + (h)) * HTB)
#define PG8_SB(b, h) ((4 + (b) * 2 + (h)) * HTB)
#define PG8_STAGE(bufoff, gbase, voff) do { _Pragma("unroll") for (int _i = 0; _i < 2; ++_i) \
        __builtin_amdgcn_global_load_lds((const unsigned*)((const char*)(gbase) + (voff)[_i]), (LAS unsigned*)(lds + (bufoff) + ldsw + _i * 8192), 16, 0, 0); } while (0)
#define PG8_LDA(dst, b, h) do { _Pragma("unroll") for (int m = 0; m < 4; ++m) _Pragma("unroll") for (int k = 0; k < 2; ++k) dst[m][k] = *(const LAS bf16x8*)(lds + PG8_SA(b, h) + aoff + m * 2048 + k * 1024); } while (0)
#define PG8_LDB(dst, b, h) do { _Pragma("unroll") for (int n = 0; n < 2; ++n) _Pragma("unroll") for (int k = 0; k < 2; ++k) dst[n][k] = *(const LAS bf16x8*)(lds + PG8_SB(b, h) + boff + n * 2048 + k * 1024); } while (0)
#define PG8_MMA(ai, bj, At, Bt) do { __builtin_amdgcn_s_setprio(1); _Pragma("unroll") for (int m = 0; m < 4; ++m) _Pragma("unroll") for (int n = 0; n < 2; ++n) _Pragma("unroll") for (int k = 0; k < 2; ++k) \
        acc[ai][bj][m][n] = __builtin_amdgcn_mfma_f32_16x16x32_bf16(Bt[n][k], At[m][k], acc[ai][bj][m][n], 0, 0, 0); __builtin_amdgcn_s_setprio(0); } while (0)
#define PG8_WAIT_V(n) asm volatile("s_waitcnt vmcnt(" #n ")" ::: "memory")
#define PG8_WAIT_L(n) asm volatile("s_waitcnt lgkmcnt(" #n ")" ::: "memory")
#define PG8_BAR __builtin_amdgcn_s_barrier()
#define PG8_SCHED __builtin_amdgcn_sched_barrier(0)
    Unit cur, nxt; int ui = 0;
    if (!S.next(0, cur)) return;
    f32x4 acc[2][2][4][2];
#pragma unroll
    for (int a = 0; a < 2; ++a)
#pragma unroll
        for (int b = 0; b < 2; ++b)
#pragma unroll
            for (int m = 0; m < 4; ++m)
#pragma unroll
                for (int n = 0; n < 2; ++n) acc[a][b][m][n] = (f32x4){0.f, 0.f, 0.f, 0.f};
    bf16x8 At[4][2], B0[2][2], B1[2][2];
    const char* cA = (const char*)g.A + (size_t)cur.pm * tstep; const char* cB = (const char*)g.Bt + (size_t)cur.pn * tstep;
    PG8_STAGE(PG8_SB(0, 0), cB, voffB); PG8_STAGE(PG8_SA(0, 0), cA, voffA); PG8_STAGE(PG8_SB(0, 1), cB + hstep, voffB); PG8_STAGE(PG8_SA(0, 1), cA + hstep, voffA);
    if (wr == 1) PG8_BAR;
    PG8_WAIT_V(4); PG8_BAR;
    PG8_STAGE(PG8_SB(1, 0), cB + kstep, voffB); PG8_STAGE(PG8_SA(1, 0), cA + kstep, voffA); PG8_STAGE(PG8_SB(1, 1), cB + hstep + kstep, voffB);
    PG8_WAIT_V(6); PG8_BAR;
    for (;;) {
        const bool has_next = S.next(ui + 1, nxt);
        const char* nA = has_next ? (const char*)g.A + (size_t)nxt.pm * tstep : cA; const char* nB = has_next ? (const char*)g.Bt + (size_t)nxt.pn * tstep : cB;
        for (int t = 0; t < nt; t += 2) {
            const bool last = (t == nt - 2);
            const char* a1 = cA + (size_t)(t + 1) * kstep;
            const char* a2 = last ? nA : cA + (size_t)(t + 2) * kstep; const char* b2 = last ? nB : cB + (size_t)(t + 2) * kstep;
            const char* a3 = a2 + kstep; const char* b3 = b2 + kstep;
            PG8_LDB(B0, 0, 0); PG8_SCHED; PG8_LDA(At, 0, 0); PG8_STAGE(PG8_SA(1, 1), a1 + hstep, voffA);
            PG8_WAIT_L(8); PG8_BAR; PG8_WAIT_L(0); PG8_MMA(0, 0, At, B0); PG8_BAR; PG8_SCHED;
            PG8_LDB(B1, 0, 1); PG8_STAGE(PG8_SB(0, 0), b2, voffB);
            PG8_BAR; PG8_WAIT_L(0); PG8_MMA(0, 1, At, B1); PG8_BAR;
            PG8_LDA(At, 0, 1); PG8_STAGE(PG8_SA(0, 0), a2, voffA);
            PG8_BAR; PG8_WAIT_L(0); PG8_MMA(1, 0, At, B0); PG8_BAR; PG8_SCHED;
            PG8_STAGE(PG8_SB(0, 1), b2 + hstep, voffB);
            PG8_WAIT_V(6); PG8_BAR; PG8_MMA(1, 1, At, B1); PG8_BAR;
            PG8_LDB(B0, 1, 0); PG8_SCHED; PG8_LDA(At, 1, 0); PG8_STAGE(PG8_SA(0, 1), a2 + hstep, voffA);
            PG8_WAIT_L(8); PG8_BAR; PG8_WAIT_L(0); PG8_MMA(0, 0, At, B0); PG8_BAR; PG8_SCHED;
            PG8_LDB(B1, 1, 1); PG8_STAGE(PG8_SB(1, 0), b3, voffB);
            PG8_BAR; PG8_WAIT_L(0); PG8_MMA(0, 1, At, B1); PG8_BAR;
            PG8_LDA(At, 1, 1); PG8_STAGE(PG8_SA(1, 0), a3, voffA);
            PG8_BAR; PG8_WAIT_L(0); PG8_MMA(1, 0, At, B0); PG8_BAR; PG8_SCHED;
            PG8_STAGE(PG8_SB(1, 1), b3 + hstep, voffB);
            PG8_WAIT_V(6); PG8_BAR; PG8_MMA(1, 1, At, B1); PG8_BAR;
        }
        E(acc, cur, wr, wc, fr, fq);
        if (!has_next) break;
#pragma unroll
        for (int a = 0; a < 2; ++a)
#pragma unroll
            for (int b = 0; b < 2; ++b)
#pragma unroll
                for (int m = 0; m < 4; ++m)
#pragma unroll
                    for (int n = 0; n < 2; ++n) acc[a][b][m][n] = (f32x4){0.f, 0.f, 0.f, 0.f};
        cur = nxt; cA = nA; cB = nB; ++ui;
    }
    PG8_WAIT_V(0);
    if (wr == 0) PG8_BAR;
    PG8_BAR;
#undef PG8_SA
#undef PG8_SB
#undef PG8_STAGE
#undef PG8_LDA
#undef PG8_LDB
#undef PG8_MMA
#undef PG8_WAIT_V
#undef PG8_WAIT_L
#undef PG8_BAR
#undef PG8_SCHED
}
}
using pg8::Unit;
typedef f32x4 Acc[2][2][4][2];

struct EpiSwiGLU {
    bf16_t* act;
    __device__ __forceinline__ void operator()(const Acc& acc, const Unit& u, int wr, int wc, int fr, int fq) const {
#pragma unroll
        for (int ai = 0; ai < 2; ++ai)
#pragma unroll
            for (int m = 0; m < 4; ++m) {
                const int row = u.pm * 256 + ai * 128 + wr * 64 + m * 16 + fr;
                bf16_t* rp = act + (size_t)row * DFF + u.pn * 128 + wc * 32 + 4 * fq;
#pragma unroll
                for (int n = 0; n < 2; ++n) {
                    const f32x4 g = acc[ai][0][m][n], up = acc[ai][1][m][n];
                    u32x2 o; o[0] = pk2(silu_f(g[0]) * up[0], silu_f(g[1]) * up[1]); o[1] = pk2(silu_f(g[2]) * up[2], silu_f(g[3]) * up[3]);
                    *(u32x2*)(rp + 16 * n) = o;
                }
            }
    }
};
struct EpiResid {
    CParams* p; int l, gi; float gs;
    __device__ __forceinline__ void operator()(const Acc& acc, const Unit& u, int wr, int wc, int fr, int fq) const {
        const int cond = cond_of_row(u.pm * 256);
        f32x4 gt[2][2];
#pragma unroll
        for (int bj = 0; bj < 2; ++bj)
#pragma unroll
            for (int n = 0; n < 2; ++n) gt[bj][n] = mod4(*p, l, cond, gi, u.pn * 256 + bj * 128 + wc * 32 + 16 * n + 4 * fq) * gs;
#pragma unroll
        for (int ai = 0; ai < 2; ++ai)
#pragma unroll
            for (int m = 0; m < 4; ++m) {
                const int row = u.pm * 256 + ai * 128 + wr * 64 + m * 16 + fr;
                float* rp = p->xres + (size_t)row * DM + u.pn * 256 + wc * 32 + 4 * fq;
#pragma unroll
                for (int bj = 0; bj < 2; ++bj)
#pragma unroll
                    for (int n = 0; n < 2; ++n) { f32x4* q = (f32x4*)(rp + bj * 128 + 16 * n); *q = *q + gt[bj][n] * acc[ai][bj][m][n]; }
            }
    }
};
__device__ __forceinline__ void rope4(f32x4& x1, f32x4& x2, float pos, int i0, float expo_scale) {
#pragma unroll
    for (int j = 0; j < 4; ++j) {
        const float inv = __builtin_amdgcn_exp2f(-LOG2_ROPE * expo_scale * (float)(i0 + j));
        const float ang = pos * inv, cs = __cosf(ang), sn = __sinf(ang);
        const float a = x1[j], b = x2[j];
        x1[j] = a * cs - b * sn; x2[j] = a * sn + b * cs;
    }
}
__device__ __forceinline__ void st4bf(bf16_t* dst, const f32x4& v) { u32x2 o; o[0] = pk2(v[0], v[1]); o[1] = pk2(v[2], v[3]); *(u32x2*)dst = o; }
struct EpiAB {
    CParams* p;
    __device__ __forceinline__ void operator()(const Acc& acc, const Unit& u, int wr, int wc, int fr, int fq) const {
        CParams& P = *p;
#pragma unroll
        for (int bj = 0; bj < 2; ++bj) {
            const int cb = u.pn * 256 + bj * 128;
#pragma unroll
            for (int ai = 0; ai < 2; ++ai)
#pragma unroll
                for (int m = 0; m < 4; ++m) {
                    const int row = u.pm * 256 + ai * 128 + wr * 64 + m * 16 + fr;
                    f32x4 v0 = acc[ai][bj][m][0], v1 = acc[ai][bj][m][1];
                    const bool lat = row >= 4096;
                    const int b = row >> 8, pos = row & 255, ts = row - 4096, bs = ts >> 11, tt = ts & 2047;
                    if (cb < 3072) {
                        const int which = cb >> 10, hh = (cb & 1023) >> 7, d0 = wc * 32 + 4 * fq;
                        if (which < 2 && lat) rope4(v0, v1, (wc & 1) ? (float)(tt & 63) : (float)(tt >> 6), 4 * fq, 1.0f / 16.0f);
                        if (which == 0) {
                            v0 = v0 * (0.125f * LOG2E); v1 = v1 * (0.125f * LOG2E);
                            bf16_t* q = lat ? P.qa_s + ((size_t)(bs * 8 + hh) * 2048 + tt) * 128 : P.qa_p + ((size_t)(b * 8 + hh) * 256 + pos) * 128;
                            st4bf(q + d0, v0); st4bf(q + d0 + 16, v1);
                        } else if (which == 1) {
                            bf16_t* q = lat ? P.ka_s + ((size_t)(bs * 8 + hh) * 2560 + 512 + tt) * 128 : P.ka_p + ((size_t)(b * 8 + hh) * 256 + pos) * 128;
                            st4bf(q + d0, v0); st4bf(q + d0 + 16, v1);
                            if (!lat) { float* o = P.new_a_k + ((size_t)(b * 8 + hh) * 256 + pos) * 128 + d0; *(f32x4*)o = v0; *(f32x4*)(o + 16) = v1; }
                        } else {
                            bf16_t* q; int ld;
                            if (lat) { q = P.vta_s + (size_t)(bs * 8 + hh) * 128 * 2560 + 512 + tt; ld = 2560; } else { q = P.vta_p + (size_t)(b * 8 + hh) * 128 * 256 + pos; ld = 256; }
#pragma unroll
                            for (int j = 0; j < 4; ++j) { q[(size_t)(d0 + j) * ld] = (bf16_t)f2bf(v0[j]); q[(size_t)(d0 + 16 + j) * ld] = (bf16_t)f2bf(v1[j]); }
                            if (!lat) { float* o = P.new_a_v + ((size_t)(b * 8 + hh) * 256 + pos) * 128 + d0; *(f32x4*)o = v0; *(f32x4*)(o + 16) = v1; }
                        }
                    } else if (cb < 6144) {
                        const int c0 = cb - 3072 + wc * 32 + 4 * fq;
                        if (cb < 3584) { v0 = v0 * 0.08838834764831845f; v1 = v1 * 0.08838834764831845f; }
                        if (cb >= 4096 && cb < 5120) {
                            bf16_t* q = P.bvt + (size_t)(c0 - 1024) * NTOK + row;
#pragma unroll
                            for (int j = 0; j < 4; ++j) { q[(size_t)j * NTOK] = (bf16_t)f2bf(v0[j]); q[(size_t)(16 + j) * NTOK] = (bf16_t)f2bf(v1[j]); }
                        } else {
                            if (cb >= 5120) {
#pragma unroll
                                for (int j = 0; j < 4; ++j) { v0[j] = silu_f(v0[j]); v1[j] = silu_f(v1[j]); }
                            }
                            bf16_t* q = P.pb + (size_t)row * 3072 + c0;
                            st4bf(q, v0); st4bf(q + 16, v1);
                        }
                    } else {
                        const int c0 = cb - 6144 + wc * 32 + 4 * fq;
                        const f32x4 b0 = *(const f32x4*)(P.alpha_b + c0), b1 = *(const f32x4*)(P.alpha_b + c0 + 16);
#pragma unroll
                        for (int j = 0; j < 4; ++j) {
                            float x = v0[j] + b0[j]; v0[j] = (fminf(x, 0.f) - __logf(1.0f + __expf(-fabsf(x)))) * (1.0f / 16.0f);
                            x = v1[j] + b1[j];       v1[j] = (fminf(x, 0.f) - __logf(1.0f + __expf(-fabsf(x)))) * (1.0f / 16.0f);
                        }
                        float* q = P.la + (size_t)row * 1024 + c0;
                        *(f32x4*)q = v0; *(f32x4*)(q + 16) = v1;
                    }
                }
        }
    }
};
struct EpiC {
    CParams* p;
    __device__ __forceinline__ void operator()(const Acc& acc, const Unit& u, int wr, int wc, int fr, int fq) const {
        CParams& P = *p;
#pragma unroll
        for (int bj = 0; bj < 2; ++bj) {
            const int cb = u.pn * 256 + bj * 128;
#pragma unroll
            for (int ai = 0; ai < 2; ++ai)
#pragma unroll
                for (int m = 0; m < 4; ++m) {
                    const int row = u.pm * 256 + ai * 128 + wr * 64 + m * 16 + fr;
                    f32x4 v0 = acc[ai][bj][m][0], v1 = acc[ai][bj][m][1];
                    const bool lat = row >= 4096;
                    const int b = row >> 8, pos = row & 255, ts = row - 4096, bs = ts >> 11, tt = ts & 2047;
                    if (cb < 2560) {
                        const int gidx = wc >> 1, i0 = 16 * (wc & 1) + 4 * fq, d1 = 64 * gidx + i0;
                        if (lat) rope4(v0, v1, gidx ? (float)(tt & 63) : (float)(tt >> 6), i0, 1.0f / 32.0f);
                        if (cb < 2048) {
                            const int hh = cb >> 7;
                            v0 = v0 * (0.08838834764831845f * LOG2E); v1 = v1 * (0.08838834764831845f * LOG2E);
                            bf16_t* q = lat ? P.qc_s + ((size_t)(bs * 16 + hh) * 2048 + tt) * 128 : P.qc_p + ((size_t)(b * 16 + hh) * 256 + pos) * 128;
                            st4bf(q + d1, v0); st4bf(q + d1 + 32, v1);
                        } else {
                            const int kv = (cb - 2048) >> 7;
                            bf16_t* q = lat ? P.kc_s + ((size_t)(bs * 4 + kv) * 2560 + 512 + tt) * 128 : P.kc_p + ((size_t)(b * 4 + kv) * 256 + pos) * 128;
                            st4bf(q + d1, v0); st4bf(q + d1 + 32, v1);
                            if (!lat) { float* o = P.new_c_k + ((size_t)(b * 4 + kv) * 256 + pos) * 128 + d1; *(f32x4*)o = v0; *(f32x4*)(o + 32) = v1; }
                        }
                    } else {
                        const int kv = (cb - 2560) >> 7, d0 = wc * 32 + 4 * fq;
                        bf16_t* q; int ld;
                        if (lat) { q = P.vtc_s + (size_t)(bs * 4 + kv) * 128 * 2560 + 512 + tt; ld = 2560; } else { q = P.vtc_p + (size_t)(b * 4 + kv) * 128 * 256 + pos; ld = 256; }
#pragma unroll
                        for (int j = 0; j < 4; ++j) { q[(size_t)(d0 + j) * ld] = (bf16_t)f2bf(v0[j]); q[(size_t)(d0 + 16 + j) * ld] = (bf16_t)f2bf(v1[j]); }
                        if (!lat) { float* o = P.new_c_v + ((size_t)(b * 4 + kv) * 256 + pos) * 128 + d0; *(f32x4*)o = v0; *(f32x4*)(o + 16) = v1; }
                    }
                }
        }
    }
};

__device__ __forceinline__ int colmap(int map, int n) {
    if (map == 1) { const int t = n >> 8, w = n & 255; return (w < 128) ? t * 128 + w : DFF + t * 128 + (w - 128); }
    if (map == 2) { if (n >= 2560) return n; const int p = n & 63, i = (p >> 5) * 16 + (p & 15), s = (p >> 4) & 1; return (n & ~63) + i + 32 * s; }
    return n;
}
template <class JobT>
__device__ __forceinline__ void transpose_tile(const JobT& J, int tl) {
    const int tid = threadIdx.x, wave = tid >> 6, lane = tid & 63;
    const int nkt = J.K >> 7, nnt = J.N >> 7;
    const int kt = tl % nkt, r = tl / nkt, nt = r % nnt, b = r / nnt;
    const float* src = J.src + (size_t)b * J.sbs; bf16_t* dst = J.dst + (size_t)b * J.dbs;
    const int nsub = wave & 3, ksub = wave >> 2, kg = lane >> 3, c4 = lane & 7;
    const int n = nt * 128 + nsub * 32 + c4 * 4, k = kt * 128 + ksub * 64 + kg * 8;
    const int sc = colmap(J.map, n);
    f32x4 v[8];
#pragma unroll
    for (int i = 0; i < 8; ++i) v[i] = *(const f32x4*)(src + (size_t)(k + i) * J.lds + sc);
#pragma unroll
    for (int e = 0; e < 4; ++e) {
        u32x4 o; o[0] = pk2(v[0][e], v[1][e]); o[1] = pk2(v[2][e], v[3][e]); o[2] = pk2(v[4][e], v[5][e]); o[3] = pk2(v[6][e], v[7][e]);
        *(u32x4*)(dst + (size_t)(n + e) * J.ldd + k) = o;
    }
}
constexpr int IT_ADA = 288, IT_XCP = 1024, IT_CK = 384, IT_WEFF = 128;
__device__ __forceinline__ void phase_prep(CParams& P, LAS unsigned char* lds) {
    const int tid = threadIdx.x, wave = tid >> 6, lane = tid & 63;
    const int total = IT_ADA + IT_XCP + IT_CK + IT_WEFF + P.n_ttiles;
    LAS float* sc = (LAS float*)lds;
    LAS float* red = (LAS float*)(lds + 12288);
    for (int it = blockIdx.x; it < total; it += gridDim.x) {
        if (it < IT_ADA) {
            const int l = it / 144, r = it % 144, strip = r >> 1, kh = r & 1;
            for (int i = tid; i < 3072; i += 512) { const int c = i >> 10, k = kh * 1024 + (i & 1023); const float x = (c == 0) ? P.c_ctx[k] : P.c[(c - 1) * DM + k]; sc[i] = silu_f(x); }
            __syncthreads();
            const int kl0 = wave * 128;
            const float* W = P.ada_w + ((size_t)l * DM + kh * 1024 + kl0) * NMODW + strip * 256 + lane * 4;
            f32x4 a0 = {0, 0, 0, 0}, a1 = a0, a2 = a0;
#pragma unroll 8
            for (int k = 0; k < 128; ++k) {
                const f32x4 w = *(const f32x4*)(W + (size_t)k * NMODW);
                a0 += w * sc[kl0 + k]; a1 += w * sc[1024 + kl0 + k]; a2 += w * sc[2048 + kl0 + k];
            }
            *(LAS f32x4*)(red + (wave * 3 + 0) * 256 + lane * 4) = a0; *(LAS f32x4*)(red + (wave * 3 + 1) * 256 + lane * 4) = a1; *(LAS f32x4*)(red + (wave * 3 + 2) * 256 + lane * 4) = a2;
            __syncthreads();
            if (tid < 256) {
                const int col = strip * 256 + tid;
                const float bias = kh == 0 ? P.ada_b[(size_t)l * NMODW + col] : 0.f;
#pragma unroll
                for (int c = 0; c < 3; ++c) { float s = bias; for (int w = 0; w < 8; ++w) s += red[(w * 3 + c) * 256 + tid]; ((float*)modp(P, kh, l, c))[col] = s; }
            }
            __syncthreads();
        } else if (it < IT_ADA + IT_XCP) {
            const int j = it - IT_ADA;
#pragma unroll
            for (int i = 0; i < 8; ++i) {
                const size_t e = (size_t)j * 16384 + (size_t)(i * 512 + tid) * 4;
                const float* s = e < (size_t)4096 * DM ? P.x_prompt + e : P.x_sample + (e - (size_t)4096 * DM);
                *(f32x4*)(P.xres + e) = *(const f32x4*)s;
            }
        } else if (it < IT_ADA + IT_XCP + IT_CK) {
            const int j = it - IT_ADA - IT_XCP;
            const bool isa = j < 256; const int jj = isa ? j : j - 256;
            const float* s = isa ? P.cache_a_k : P.cache_c_k; bf16_t* d = isa ? P.ka_s : P.kc_s;
            const size_t e = (size_t)jj * 4096 + (size_t)tid * 8;
            const size_t bh = e >> 16, rem = e & 65535;
            const f32x4 v0 = *(const f32x4*)(s + e), v1 = *(const f32x4*)(s + e + 4);
            u32x4 o; o[0] = pk2(v0[0], v0[1]); o[1] = pk2(v0[2], v0[3]); o[2] = pk2(v1[0], v1[1]); o[3] = pk2(v1[2], v1[3]);
            *(u32x4*)(d + bh * (size_t)(2560 * 128) + rem) = o;
        } else if (it < IT_ADA + IT_XCP + IT_CK + IT_WEFF) {
            const int j = it - IT_ADA - IT_XCP - IT_CK;
            const int dir = (j * 8) >> 9;
            for (int kk = 0; kk < 4; ++kk) {
                const int k = tid + 512 * kk;
                float wl[16];
#pragma unroll
                for (int q = 0; q < 4; ++q) { const f32x4 t = *(const f32x4*)(P.ab_w_in + (size_t)k * 6176 + 6144 + 16 * dir + 4 * q); wl[4 * q] = t[0]; wl[4 * q + 1] = t[1]; wl[4 * q + 2] = t[2]; wl[4 * q + 3] = t[3]; }
#pragma unroll
                for (int jj = 0; jj < 8; ++jj) {
                    const int n = (j * 8 + jj) & 511; float s = 0.f;
#pragma unroll
                    for (int r = 0; r < 16; ++r) s += wl[r] * P.alpha_w[(size_t)(dir * 16 + r) * 512 + n];
                    P.wt_ab[(size_t)(6144 + j * 8 + jj) * DM + k] = (bf16_t)f2bf(s);
                }
            }
        } else {
            const int tl = it - (IT_ADA + IT_XCP + IT_CK + IT_WEFF);
            int ji = 0;
            for (int q = 1; q < 14; ++q) if (tl >= P.jobs[q].tile0) ji = q;
            transpose_tile(P.jobs[ji], tl - P.jobs[ji].tile0);
        }
    }
}

__device__ __forceinline__ void phase_norm(CParams& P, int l, int which, int si) {
    const int tid = threadIdx.x, wave = tid >> 6, lane = tid & 63;
    const float* g = P.norm_g + (size_t)(l * 3 + which) * DM;
    for (int row = blockIdx.x * 8 + wave; row < NTOK; row += gridDim.x * 8) {
        const float* xp = P.xres + (size_t)row * DM;
        const int cond = cond_of_row(row);
        f32x4 v[8]; float ss = 0.f;
#pragma unroll
        for (int i = 0; i < 8; ++i) { v[i] = *(const f32x4*)(xp + 4 * lane + 256 * i); ss += v[i][0] * v[i][0] + v[i][1] * v[i][1] + v[i][2] * v[i][2] + v[i][3] * v[i][3]; }
#pragma unroll
        for (int o = 32; o >= 1; o >>= 1) ss += __shfl_xor(ss, o, 64);
        const float rstd = rsqrtf(ss * (1.0f / DM) + 1e-6f);
#pragma unroll
        for (int i = 0; i < 8; ++i) {
            const int col = 4 * lane + 256 * i;
            const f32x4 gg = *(const f32x4*)(g + col), sh = mod4(P, l, cond, si, col), scl = mod4(P, l, cond, si + 1, col);
            const f32x4 y = (v[i] * rstd) * gg * (scl + 1.0f) + sh;
            st4bf(P.h + (size_t)row * DM + col, y);
        }
    }
}
__device__ __forceinline__ void phase_final_norm(CParams& P) {
    const int tid = threadIdx.x, wave = tid >> 6, lane = tid & 63;
    for (int row = blockIdx.x * 8 + wave; row < NTOK; row += gridDim.x * 8) {
        const float* xp = P.xres + (size_t)row * DM;
        f32x4 v[8]; float ss = 0.f;
#pragma unroll
        for (int i = 0; i < 8; ++i) { v[i] = *(const f32x4*)(xp + 4 * lane + 256 * i); ss += v[i][0] * v[i][0] + v[i][1] * v[i][1] + v[i][2] * v[i][2] + v[i][3] * v[i][3]; }
#pragma unroll
        for (int o = 32; o >= 1; o >>= 1) ss += __shfl_xor(ss, o, 64);
        const float rstd = rsqrtf(ss * (1.0f / DM) + 1e-6f);
#pragma unroll
        for (int i = 0; i < 8; ++i) { const int col = 4 * lane + 256 * i; *(f32x4*)(P.y + (size_t)row * DM + col) = (v[i] * rstd) * *(const f32x4*)(P.final_g + col); }
    }
}
__device__ __forceinline__ void phase_gla_merge(CParams& P) {
    const int tid = threadIdx.x, wave = tid >> 6, lane = tid & 63;
    for (int it = blockIdx.x * 8 + wave; it < NTOK * 4; it += gridDim.x * 8) {
        const int row = it >> 2, hh = it & 3, col = hh * 256 + 4 * lane;
        const f32x4 a = *(const f32x4*)(P.of + (size_t)row * 1024 + col) + *(const f32x4*)(P.ob + (size_t)row * 1024 + col);
        float ss = a[0] * a[0] + a[1] * a[1] + a[2] * a[2] + a[3] * a[3];
#pragma unroll
        for (int o = 32; o >= 1; o >>= 1) ss += __shfl_xor(ss, o, 64);
        const float rstd = rsqrtf(ss * (1.0f / 256.0f) + 1e-6f);
        const f32x4 g = *(const f32x4*)(P.b_norm_g + 4 * lane);
        const u32x2 br = *(const u32x2*)(P.pb + (size_t)row * 3072 + 2048 + col);
        f32x4 r; r[0] = __uint_as_float(br[0] << 16); r[1] = __uint_as_float(br[0] & 0xffff0000u); r[2] = __uint_as_float(br[1] << 16); r[3] = __uint_as_float(br[1] & 0xffff0000u);
        st4bf(P.mo + (size_t)row * DM + 1024 + col, a * rstd * g * r);
    }
}

constexpr int KS_BYTES = 64 * 136 * 2, VS_BYTES = 128 * 72 * 2, VS_OFF = 2 * KS_BYTES;
template <int DQ>
__device__ __forceinline__ void attn_pass(LAS unsigned char* lds, const bf16_t* Qw, int ldq, const bf16_t* Kb, int ldk, const bf16_t* Vt, int ldv,
                                          int nt, int t_band0, int kidx_band0, int kp_band0, int qpos, int qw0,
                                          float m0, float l0, f32x16 (&o)[4], float& l_out) {
    const int tid = threadIdx.x, lane = tid & 63, h = lane >> 5, r31 = lane & 31;
    constexpr int KROW = DQ + 8, KCH = DQ / 8, NKC = (64 * KCH) / 512;
    bf16x8 qf[DQ / 16];
#pragma unroll
    for (int ks = 0; ks < DQ / 16; ++ks) qf[ks] = *(const bf16x8*)(Qw + (size_t)r31 * ldq + 16 * ks + 8 * h);
#pragma unroll
    for (int dt = 0; dt < 4; ++dt)
#pragma unroll
        for (int i = 0; i < 16; ++i) o[dt][i] = 0.f;
    float m = m0, l = l0;
    u32x4 kreg[NKC], vreg[2];
    auto kidx_of = [&](int t) { return t < t_band0 ? 64 * t : kidx_band0 + 64 * (t - t_band0); };
    auto load_regs = [&](int t) {
        const int k0 = kidx_of(t);
#pragma unroll
        for (int i = 0; i < NKC; ++i) { const int c = tid + 512 * i, key = c / KCH, ch = c % KCH; kreg[i] = *(const u32x4*)(Kb + (size_t)(k0 + key) * ldk + 8 * ch); }
#pragma unroll
        for (int i = 0; i < 2; ++i) { const int c = tid + 512 * i, d = c >> 3, ch = c & 7; vreg[i] = *(const u32x4*)(Vt + (size_t)d * ldv + k0 + 8 * ch); }
    };
    auto store_lds = [&](int buf) {
#pragma unroll
        for (int i = 0; i < NKC; ++i) { const int c = tid + 512 * i, key = c / KCH, ch = c % KCH; *(LAS u32x4*)(lds + buf * KS_BYTES + (key * KROW + 8 * ch) * 2) = kreg[i]; }
#pragma unroll
        for (int i = 0; i < 2; ++i) { const int c = tid + 512 * i, d = c >> 3, ch = c & 7; *(LAS u32x4*)(lds + VS_OFF + buf * VS_BYTES + (d * 72 + 8 * ch) * 2) = vreg[i]; }
    };
    __syncthreads();
    load_regs(0); store_lds(0);
    __syncthreads();
    for (int t = 0; t < nt; ++t) {
        const int buf = t & 1;
        if (t + 1 < nt) load_regs(t + 1);
        const bool band = t >= t_band0;
        const int kp0 = kp_band0 + 64 * (t - t_band0);
        const bool skip = band && (kp0 > qw0 + 31 + 128 || kp0 + 63 < qw0 - 128);
        if (!skip) {
            f32x16 s[2];
#pragma unroll
            for (int kt = 0; kt < 2; ++kt) {
#pragma unroll
                for (int i = 0; i < 16; ++i) s[kt][i] = 0.f;
#pragma unroll
                for (int ks = 0; ks < DQ / 16; ++ks) {
                    const bf16x8 a = *(const LAS bf16x8*)(lds + buf * KS_BYTES + ((kt * 32 + r31) * KROW + 16 * ks + 8 * h) * 2);
                    s[kt] = mfma32(a, qf[ks], s[kt]);
                }
            }
            if (band) {
#pragma unroll
                for (int kt = 0; kt < 2; ++kt)
#pragma unroll
                    for (int i = 0; i < 16; ++i) { const int kp = kp0 + 32 * kt + (i & 3) + 8 * (i >> 2) + 4 * h; const int dlt = qpos - kp; if (dlt > 128 || dlt < -128) s[kt][i] = -1e30f; }
            }
            float mx = s[0][0];
#pragma unroll
            for (int kt = 0; kt < 2; ++kt)
#pragma unroll
                for (int i = 0; i < 16; ++i) mx = fmaxf(mx, s[kt][i]);
            mx = fmaxf(mx, xor32(mx));
            const float mn = fmaxf(m, mx), alpha = __builtin_amdgcn_exp2f(m - mn);
            m = mn;
            float ps = 0.f;
#pragma unroll
            for (int kt = 0; kt < 2; ++kt)
#pragma unroll
                for (int i = 0; i < 16; ++i) { const float pv = __builtin_amdgcn_exp2f(s[kt][i] - mn); s[kt][i] = pv; ps += pv; }
            l = l * alpha + ps;
#pragma unroll
            for (int dt = 0; dt < 4; ++dt)
#pragma unroll
                for (int i = 0; i < 16; ++i) o[dt][i] *= alpha;
            bf16x8 pb[2][2];
#pragma unroll
            for (int kt = 0; kt < 2; ++kt) { pb[kt][0] = pack8(s[kt], 0); pb[kt][1] = pack8(s[kt], 8); }
#pragma unroll
            for (int dt = 0; dt < 4; ++dt)
#pragma unroll
                for (int kt = 0; kt < 2; ++kt)
#pragma unroll
                    for (int s2 = 0; s2 < 2; ++s2) {
                        const LAS unsigned char* vp = lds + VS_OFF + buf * VS_BYTES + ((dt * 32 + r31) * 72 + 32 * kt + 16 * s2 + 4 * h) * 2;
                        const u32x2 lo = *(const LAS u32x2*)vp, hi = *(const LAS u32x2*)(vp + 16);
                        u32x4 av; av[0] = lo[0]; av[1] = lo[1]; av[2] = hi[0]; av[3] = hi[1];
                        o[dt] = mfma32(__builtin_bit_cast(bf16x8, av), pb[kt][s2], o[dt]);
                    }
        }
        if (t + 1 < nt) store_lds(buf ^ 1);
        __syncthreads();
    }
    l_out = l + xor32(l);
}

__device__ __forceinline__ void diff_attn_item(CParams& P, LAS unsigned char* lds, int item, float lam, float lam_init) {
    const int tid = threadIdx.x, wave = tid >> 6, lane = tid & 63, h = lane >> 5, r31 = lane & 31;
    const bf16_t *Q, *K, *Vt; int nk, row0;
    if (item < 128) { const int bh = item >> 3, qt = item & 7; Q = P.qa_s + ((size_t)bh * 2048 + qt * 256) * 128; K = P.ka_s + (size_t)bh * 2560 * 128; Vt = P.vta_s + (size_t)bh * 128 * 2560; nk = 2560; row0 = 4096 + (bh >> 3) * 2048 + qt * 256; }
    else { const int bh = item - 128; Q = P.qa_p + (size_t)bh * 256 * 128; K = P.ka_p + (size_t)bh * 256 * 128; Vt = P.vta_p + (size_t)bh * 128 * 256; nk = 256; row0 = (bh >> 3) * 256; }
    const int hh = (item < 128 ? (item >> 3) : (item - 128)) & 7;
    f32x16 o1[4]; float l1, l2;
    f32x4* park = (f32x4*)P.park + (size_t)blockIdx.x * 16 * 512 + tid;
    attn_pass<64>(lds, Q + (size_t)(wave * 32) * 128, 128, K, 128, Vt, nk, nk / 64, nk / 64, 0, 0, 0, 0, -1e30f, 0.f, o1, l1);
    {
        const float i1 = 1.0f / l1;
#pragma unroll
        for (int dt = 0; dt < 4; ++dt)
#pragma unroll
            for (int g = 0; g < 4; ++g) { f32x4 v; v[0] = o1[dt][4 * g] * i1; v[1] = o1[dt][4 * g + 1] * i1; v[2] = o1[dt][4 * g + 2] * i1; v[3] = o1[dt][4 * g + 3] * i1; park[(dt * 4 + g) * 512] = v; }
    }
    attn_pass<64>(lds, Q + (size_t)(wave * 32) * 128 + 64, 128, K + 64, 128, Vt, nk, nk / 64, nk / 64, 0, 0, 0, 0, -1e30f, 0.f, o1, l2);
    const float i2 = lam / l2;
    float ss = 0.f;
#pragma unroll
    for (int dt = 0; dt < 4; ++dt)
#pragma unroll
        for (int g = 0; g < 4; ++g) {
            const f32x4 v = park[(dt * 4 + g) * 512];
#pragma unroll
            for (int j = 0; j < 4; ++j) { const float a = v[j] - o1[dt][4 * g + j] * i2; o1[dt][4 * g + j] = a; ss += a * a; }
        }
    ss += xor32(ss);
    const float sc = rsqrtf(ss * (1.0f / 128.0f) + 1e-6f) * (1.0f - lam_init);
    bf16_t* dst = P.mo + (size_t)(row0 + wave * 32 + r31) * DM + hh * 128;
#pragma unroll
    for (int dt = 0; dt < 4; ++dt)
#pragma unroll
        for (int g = 0; g < 4; ++g) {
            const int d = 32 * dt + 8 * g + 4 * h;
            const f32x4 gg = *(const f32x4*)(P.a_subln_g + d);
            f32x4 v; v[0] = o1[dt][4 * g] * sc * gg[0]; v[1] = o1[dt][4 * g + 1] * sc * gg[1]; v[2] = o1[dt][4 * g + 2] * sc * gg[2]; v[3] = o1[dt][4 * g + 3] * sc * gg[3];
            st4bf(dst + d, v);
        }
}
__device__ __forceinline__ void sink_attn_item(CParams& P, LAS unsigned char* lds, int item) {
    const int tid = threadIdx.x, wave = tid >> 6, lane = tid & 63, h = lane >> 5, r31 = lane & 31;
    f32x16 o[4]; float l; int row0, hh;
    if (item < 256) {
        const int bs = item >> 7, qt = item & 7; hh = (item >> 3) & 15; const int kv = hh >> 2, q0 = qt * 256;
        const bf16_t* Q = P.qc_s + ((size_t)(bs * 16 + hh) * 2048 + q0 + wave * 32) * 128;
        const bf16_t* K = P.kc_s + (size_t)(bs * 4 + kv) * 2560 * 128; const bf16_t* Vt = P.vtc_s + (size_t)(bs * 4 + kv) * 128 * 2560;
        const int lo = q0 - 128 < 0 ? 0 : q0 - 128, hi = q0 + 384 > 2048 ? 2048 : q0 + 384;
        const float sk = P.c_sink[hh] * LOG2E;
        attn_pass<128>(lds, Q, 128, K, 128, Vt, 2560, 8 + (hi - lo) / 64, 8, 512 + lo, lo, q0 + wave * 32 + r31, q0 + wave * 32, sk, 0.5f, o, l);
        row0 = 4096 + bs * 2048 + q0;
    } else {
        const int bh = item - 256, b = bh >> 4; hh = bh & 15; const int kv = hh >> 2;
        const bf16_t* Q = P.qc_p + ((size_t)bh * 256 + wave * 32) * 128;
        const bf16_t* K = P.kc_p + (size_t)(b * 4 + kv) * 256 * 128; const bf16_t* Vt = P.vtc_p + (size_t)(b * 4 + kv) * 128 * 256;
        const float sk = P.c_sink[hh] * LOG2E;
        attn_pass<128>(lds, Q, 128, K, 128, Vt, 256, 4, 4, 0, 0, 0, 0, sk, 0.5f, o, l);
        row0 = b * 256;
    }
    const float il = 1.0f / l;
    bf16_t* dst = P.mo + (size_t)(row0 + wave * 32 + r31) * DM + hh * 128;
#pragma unroll
    for (int dt = 0; dt < 4; ++dt)
#pragma unroll
        for (int g = 0; g < 4; ++g) {
            f32x4 v; v[0] = o[dt][4 * g] * il; v[1] = o[dt][4 * g + 1] * il; v[2] = o[dt][4 * g + 2] * il; v[3] = o[dt][4 * g + 3] * il;
            st4bf(dst + 32 * dt + 8 * g + 4 * h, v);
        }
}

constexpr int G_QD = 0, G_KD = 8704, G_KDT = 17408, G_AD = 27648, G_BUF = 28160;
__device__ __forceinline__ void gla_item(CParams& P, LAS unsigned char* lds, int item) {
    const int tid = threadIdx.x, wave = tid >> 6, lane = tid & 63, h = lane >> 5, r31 = lane & 31;
    int row0, nch, hh, dir, sidx; bool lat;
    if (item < 16) { lat = true; sidx = item >> 3; hh = (item >> 1) & 3; dir = item & 1; row0 = 4096 + sidx * 2048; nch = 64; }
    else { lat = false; const int j = item - 16; sidx = j >> 3; hh = (j >> 1) & 3; dir = j & 1; row0 = sidx * 256; nch = 8; }
    const int eg = hh * 256 + wave * 32 + r31;
    f32x16 S[4];
    if (lat) {
        const float* st = (dir ? P.state_b : P.state_f) + (size_t)(sidx * 4 + hh) * 128 * 256 + wave * 32 + r31;
#pragma unroll
        for (int dt = 0; dt < 4; ++dt)
#pragma unroll
            for (int i = 0; i < 16; ++i) S[dt][i] = st[(size_t)(32 * dt + (i & 3) + 8 * (i >> 2) + 4 * h) * 256];
    } else {
#pragma unroll
        for (int dt = 0; dt < 4; ++dt)
#pragma unroll
            for (int i = 0; i < 16; ++i) S[dt][i] = 0.f;
    }
    const int pd = tid & 127, pg = tid >> 7;
    const bf16_t* QK = P.pb + hh * 128 + pd;
    const bf16_t* vbase = P.bvt + (size_t)eg * NTOK;
    const float* LC = P.lacum + (size_t)dir * 512 + hh * 128 + pd;
    for (int task = tid; task < nch * 128; task += 512) {
        const int tch = task >> 7, td = task & 127, tok0 = row0 + 32 * tch;
        const float* src = P.la + (size_t)dir * 512 + hh * 128 + td; float* dstc = P.lacum + (size_t)dir * 512 + hh * 128 + td;
        float v[32];
#pragma unroll
        for (int j2 = 0; j2 < 32; ++j2) v[j2] = src[(size_t)(tok0 + (dir ? 31 - j2 : j2)) * 1024];
        float run = 0.f;
#pragma unroll
        for (int j2 = 0; j2 < 32; ++j2) { run += v[j2]; dstc[(size_t)(tok0 + (dir ? 31 - j2 : j2)) * 1024] = run; }
    }
    float own[8]; bf16_t pq[8], pk[8];
    u32x2 vn_lo[2], vn_hi[2]; bf16x8 vn_b[2];
    auto prep_load = [&](int c) {
        const int ch = dir ? nch - 1 - c : c, tok0 = row0 + 32 * ch;
#pragma unroll
        for (int jj = 0; jj < 8; ++jj) {
            const int j2 = 8 * pg + jj, i = dir ? 31 - j2 : j2;
            own[jj] = LC[(size_t)(tok0 + i) * 1024];
            pq[jj] = QK[(size_t)(tok0 + i) * 3072]; pk[jj] = QK[(size_t)(tok0 + i) * 3072 + 512];
        }
        const bf16_t* vrow = vbase + tok0;
#pragma unroll
        for (int s2 = 0; s2 < 2; ++s2) { vn_lo[s2] = *(const u32x2*)(vrow + 16 * s2 + 4 * h); vn_hi[s2] = *(const u32x2*)(vrow + 16 * s2 + 8 + 4 * h); vn_b[s2] = *(const bf16x8*)(vrow + 16 * s2 + 8 * h); }
    };
    auto prep_finish = [&](int buf) {
        LAS unsigned char* B = lds + buf * G_BUF;
        float cum = 0.f;
        unsigned kp[8];
#pragma unroll
        for (int jj = 0; jj < 8; ++jj) {
            const int j2 = 8 * pg + jj, i = dir ? 31 - j2 : j2;
            cum = own[jj];
            const unsigned qd = f2bf(bf2f(pq[jj]) * __expf(cum)), kd = f2bf(bf2f(pk[jj]) * __expf(-cum));
            *(LAS bf16_t*)(B + G_QD + (i * 136 + pd) * 2) = (bf16_t)qd;
            *(LAS bf16_t*)(B + G_KD + (i * 136 + pd) * 2) = (bf16_t)kd;
            kp[jj] = kd;
        }
        const int i8 = dir ? 24 - 8 * pg : 8 * pg;
        u32x4 o;
        o[0] = dir ? (kp[7] | (kp[6] << 16)) : (kp[0] | (kp[1] << 16)); o[1] = dir ? (kp[5] | (kp[4] << 16)) : (kp[2] | (kp[3] << 16));
        o[2] = dir ? (kp[3] | (kp[2] << 16)) : (kp[4] | (kp[5] << 16)); o[3] = dir ? (kp[1] | (kp[0] << 16)) : (kp[6] | (kp[7] << 16));
        *(LAS u32x4*)(B + G_KDT + (pd * 40 + i8) * 2) = o;
        if (pg == 3) *(LAS float*)(B + G_AD + pd * 4) = __expf(cum);
    };
    __syncthreads();
    prep_load(0); prep_finish(0);
    u32x2 vc_lo[2], vc_hi[2]; bf16x8 vc_b[2];
#pragma unroll
    for (int s2 = 0; s2 < 2; ++s2) { vc_lo[s2] = vn_lo[s2]; vc_hi[s2] = vn_hi[s2]; vc_b[s2] = vn_b[s2]; }
    __syncthreads();
    float* OUT = dir ? P.ob : P.of;
    for (int c = 0; c < nch; ++c) {
        const int buf = c & 1;
        if (c + 1 < nch) prep_load(c + 1);
        const LAS unsigned char* B = lds + buf * G_BUF;
        const int ch = dir ? nch - 1 - c : c, tok0 = row0 + 32 * ch;
        f32x16 sT;
#pragma unroll
        for (int i = 0; i < 16; ++i) sT[i] = 0.f;
#pragma unroll
        for (int ks = 0; ks < 8; ++ks) {
            const bf16x8 a = *(const LAS bf16x8*)(B + G_KD + (r31 * 136 + 16 * ks + 8 * h) * 2);
            const bf16x8 b = *(const LAS bf16x8*)(B + G_QD + (r31 * 136 + 16 * ks + 8 * h) * 2);
            sT = mfma32(a, b, sT);
        }
#pragma unroll
        for (int i = 0; i < 16; ++i) { const int s = (i & 3) + 8 * (i >> 2) + 4 * h; const bool keep = dir ? (s >= r31) : (s <= r31); if (!keep) sT[i] = 0.f; }
        bf16x8 pb[2]; pb[0] = pack8(sT, 0); pb[1] = pack8(sT, 8);
        f32x16 oT;
#pragma unroll
        for (int i = 0; i < 16; ++i) oT[i] = 0.f;
#pragma unroll
        for (int dt = 0; dt < 4; ++dt)
#pragma unroll
            for (int s2 = 0; s2 < 2; ++s2) {
                const LAS unsigned char* qp = B + G_QD + (r31 * 136 + 32 * dt + 16 * s2 + 4 * h) * 2;
                const u32x2 lo = *(const LAS u32x2*)qp, hi = *(const LAS u32x2*)(qp + 16);
                u32x4 bv; bv[0] = lo[0]; bv[1] = lo[1]; bv[2] = hi[0]; bv[3] = hi[1];
                oT = mfma32(pack8(S[dt], 8 * s2), __builtin_bit_cast(bf16x8, bv), oT);
            }
#pragma unroll
        for (int s2 = 0; s2 < 2; ++s2) {
            u32x4 av; av[0] = vc_lo[s2][0]; av[1] = vc_lo[s2][1]; av[2] = vc_hi[s2][0]; av[3] = vc_hi[s2][1];
            oT = mfma32(__builtin_bit_cast(bf16x8, av), pb[s2], oT);
        }
        {
            float* op = OUT + (size_t)(tok0 + r31) * 1024 + hh * 256 + wave * 32 + 4 * h;
#pragma unroll
            for (int g = 0; g < 4; ++g) { f32x4 v; v[0] = oT[4 * g]; v[1] = oT[4 * g + 1]; v[2] = oT[4 * g + 2]; v[3] = oT[4 * g + 3]; *(f32x4*)(op + 8 * g) = v; }
        }
#pragma unroll
        for (int s2 = 0; s2 < 2; ++s2) {
#pragma unroll
            for (int dt = 0; dt < 4; ++dt) {
                const bf16x8 a = *(const LAS bf16x8*)(B + G_KDT + ((32 * dt + r31) * 40 + 16 * s2 + 8 * h) * 2);
                S[dt] = mfma32(a, vc_b[s2], S[dt]);
            }
        }
#pragma unroll
        for (int dt = 0; dt < 4; ++dt)
#pragma unroll
            for (int g = 0; g < 4; ++g) {
                const f32x4 ad = *(const LAS f32x4*)(B + G_AD + (32 * dt + 8 * g + 4 * h) * 4);
                S[dt][4 * g] *= ad[0]; S[dt][4 * g + 1] *= ad[1]; S[dt][4 * g + 2] *= ad[2]; S[dt][4 * g + 3] *= ad[3];
            }
        if (c + 1 < nch) {
            prep_finish(buf ^ 1);
#pragma unroll
            for (int s2 = 0; s2 < 2; ++s2) { vc_lo[s2] = vn_lo[s2]; vc_hi[s2] = vn_hi[s2]; vc_b[s2] = vn_b[s2]; }
        }
        __syncthreads();
    }
    if (!lat) {
        float* st = (dir ? P.new_b_b : P.new_b_f) + (size_t)(sidx * 4 + hh) * 128 * 256 + wave * 32 + r31;
#pragma unroll
        for (int dt = 0; dt < 4; ++dt)
#pragma unroll
            for (int i = 0; i < 16; ++i) st[(size_t)(32 * dt + (i & 3) + 8 * (i >> 2) + 4 * h) * 256] = S[dt][i];
    }
}

__device__ __forceinline__ void phase_mix0(CParams& P, LAS unsigned char* lds) {
    if (blockIdx.x < 144) gla_item(P, lds, blockIdx.x);
    if (blockIdx.x < 16) return;
    const float* lp = P.a_lambda;
    float s1 = 0.f, s2 = 0.f;
    for (int i = 0; i < 64; ++i) { s1 += lp[i] * lp[64 + i]; s2 += lp[128 + i] * lp[192 + i]; }
    const float lam_init = 0.2f, lam = __expf(s1) - __expf(s2) + lam_init;
    for (int it = blockIdx.x - 16; it < 256; it += gridDim.x - 16) diff_attn_item(P, lds, it, lam, lam_init);
}
__device__ __forceinline__ void phase_mix1(CParams& P, LAS unsigned char* lds) {
    for (int it = blockIdx.x; it < 512; it += gridDim.x) sink_attn_item(P, lds, it);
}

__global__ void __launch_bounds__(512, 2) fwd_megakernel(const Params Pk) {
    extern __shared__ __attribute__((aligned(16))) unsigned char shm[];
    LAS unsigned char* lds = (LAS unsigned char*)shm;
    cg::grid_group grid = cg::this_grid();
    CParams* kp = (CParams*)__builtin_amdgcn_kernarg_segment_ptr();
    const int phase_lo = Pk.phase_lo, phase_hi = Pk.phase_hi;
    int ph = 0;
#define PHASE(...) do { if (ph >= phase_lo && ph < phase_hi) { { CParams* pp = kp; asm volatile("" : "+s"(pp)); CParams& P = *pp; __VA_ARGS__; } if (ph + 1 < phase_hi) { grid.sync(); if (REP_SYNC >= 2) grid.sync(); } } ++ph; } while (0)
#define PHASE_R(REP, ...) do { PHASE(__VA_ARGS__); if ((REP) >= 2) PHASE(__VA_ARGS__); } while (0)
#define GEMM(EpiT, epi, Aptr, Btptr, Nn, Kk) do { pg8::Gemm g{Aptr, Btptr, NTOK, Nn, Kk}; pg8::StaticOrder S; S.init(NTOK, Nn, gridDim.x, blockIdx.x); EpiT E = epi; pg8::gemm_phase<EpiT>(lds, g, S, E); } while (0)
#define LAYER_HEAD(l) \
        PHASE_R(REP_NORM, phase_norm(P, l, 0, 0)); \
        PHASE_R(REP_FFNIN, GEMM(EpiSwiGLU, (EpiSwiGLU{P.act}), P.h, P.wt_in + (size_t)(l * 2) * 2 * DFF * DM, 2 * DFF, DM)); \
        PHASE(GEMM(EpiResid, (EpiResid{&P, l, 2, 0.5f}), P.act, P.wt_out + (size_t)(l * 2) * DM * DFF, DM, DFF)); \
        PHASE_R(REP_NORM, phase_norm(P, l, 1, 3));
#define LAYER_TAIL(l) \
        PHASE_R(REP_NORM, phase_norm(P, l, 2, 6)); \
        PHASE_R(REP_FFNIN, GEMM(EpiSwiGLU, (EpiSwiGLU{P.act}), P.h, P.wt_in + (size_t)(l * 2 + 1) * 2 * DFF * DM, 2 * DFF, DM)); \
        PHASE(GEMM(EpiResid, (EpiResid{&P, l, 8, 0.5f}), P.act, P.wt_out + (size_t)(l * 2 + 1) * DM * DFF, DM, DFF));
    PHASE_R(REP_PREP, phase_prep(P, lds));
    LAYER_HEAD(0)
    PHASE(GEMM(EpiAB, (EpiAB{&P}), P.h, P.wt_ab, 7168, DM));
    PHASE_R(REP_MIX0, phase_mix0(P, lds));
    PHASE_R(REP_NORM, phase_gla_merge(P));
    PHASE(GEMM(EpiResid, (EpiResid{&P, 0, 5, 1.0f}), P.mo, P.wt_abo, DM, DM));
    LAYER_TAIL(0)
    LAYER_HEAD(1)
    PHASE(GEMM(EpiC, (EpiC{&P}), P.h, P.wt_c, 3072, DM));
    PHASE_R(REP_MIX1, phase_mix1(P, lds));
    PHASE(GEMM(EpiResid, (EpiResid{&P, 1, 5, 1.0f}), P.mo, P.wt_co, DM, DM));
    LAYER_TAIL(1)
    PHASE_R(REP_NORM, phase_final_norm(P));
}
constexpr int N_PHASES = 1 + 11 + 10 + 1;

extern "C" void kernel_launch(void* const* d_in, const int* in_sizes, int n_in, void* d_out, int out_size, void* d_ws, size_t ws_size, hipStream_t stream) {
    Params p; memset(&p, 0, sizeof(p));
    const float* const* in = (const float* const*)d_in;
    p.x_prompt = in[0]; p.x_sample = in[1]; p.cache_a_k = in[2]; p.cache_a_v = in[3]; p.state_f = in[4]; p.state_b = in[5]; p.cache_c_k = in[6]; p.cache_c_v = in[7]; p.c = in[8]; p.c_ctx = in[9];
    p.ada_w = in[10]; p.ada_b = in[11]; p.norm_g = in[12]; p.ffn_w_in = in[13]; p.ffn_w_out = in[14]; p.ab_w_in = in[15]; p.ab_w_out = in[16]; p.a_lambda = in[17]; p.a_subln_g = in[18];
    p.alpha_w = in[19]; p.alpha_b = in[20]; p.b_norm_g = in[21]; p.c_w_in = in[22]; p.c_w_out = in[23]; p.c_sink = in[24]; p.final_g = in[25];
    float* out = (float*)d_out;
    p.y = out; p.new_a_k = out + 16777216; p.new_a_v = p.new_a_k + 4194304; p.new_b_f = p.new_a_v + 4194304; p.new_b_b = p.new_b_f + 2097152; p.new_c_k = p.new_b_b + 2097152; p.new_c_v = p.new_c_k + 2097152;
    char* w = (char*)d_ws; size_t off = 0;
    auto take = [&](size_t bytes) { char* r = w + off; off += (bytes + 255) & ~(size_t)255; return r; };
    p.mods = (float*)take((size_t)2 * 2 * 3 * NMODW * 4);
    p.xres = (float*)take((size_t)NTOK * DM * 4);
    p.h = (bf16_t*)take((size_t)NTOK * DM * 2);
    p.act = (bf16_t*)take((size_t)NTOK * DFF * 2);
    p.mo = (bf16_t*)take((size_t)NTOK * DM * 2);
    p.wt_in = (bf16_t*)take((size_t)4 * 2 * DFF * DM * 2);
    p.wt_out = (bf16_t*)take((size_t)4 * DM * DFF * 2);
    p.wt_ab = (bf16_t*)take((size_t)7168 * DM * 2);
    p.wt_abo = (bf16_t*)take((size_t)DM * DM * 2);
    p.wt_c = (bf16_t*)take((size_t)3072 * DM * 2);
    p.wt_co = (bf16_t*)take((size_t)DM * DM * 2);
    p.qa_p = (bf16_t*)take((size_t)16 * 8 * 256 * 128 * 2); p.ka_p = (bf16_t*)take((size_t)16 * 8 * 256 * 128 * 2); p.vta_p = (bf16_t*)take((size_t)16 * 8 * 256 * 128 * 2);
    p.qa_s = (bf16_t*)take((size_t)2 * 8 * 2048 * 128 * 2); p.ka_s = (bf16_t*)take((size_t)2 * 8 * 2560 * 128 * 2); p.vta_s = (bf16_t*)take((size_t)2 * 8 * 2560 * 128 * 2);
    p.qc_p = (bf16_t*)take((size_t)16 * 16 * 256 * 128 * 2); p.kc_p = (bf16_t*)take((size_t)16 * 4 * 256 * 128 * 2); p.vtc_p = (bf16_t*)take((size_t)16 * 4 * 256 * 128 * 2);
    p.qc_s = (bf16_t*)take((size_t)2 * 16 * 2048 * 128 * 2); p.kc_s = (bf16_t*)take((size_t)2 * 4 * 2560 * 128 * 2); p.vtc_s = (bf16_t*)take((size_t)2 * 4 * 2560 * 128 * 2);
    p.pb = (bf16_t*)take((size_t)NTOK * 3072 * 2);
    p.bvt = (bf16_t*)take((size_t)1024 * NTOK * 2);
    p.la = (float*)take((size_t)NTOK * 1024 * 4);
    p.lacum = (float*)take((size_t)NTOK * 1024 * 4);
    p.of = (float*)take((size_t)NTOK * 1024 * 4);
    p.ob = (float*)take((size_t)NTOK * 1024 * 4);
    p.park = (float*)take((size_t)512 * 16 * 512 * 16);
    int nj = 0, t0 = 0;
    auto job = [&](const float* src, bf16_t* dst, int lds_, int K, int N, int ldd, int map, int nb, long long sbs, long long dbs) {
        TJob& J = p.jobs[nj++]; J.src = src; J.dst = dst; J.lds = lds_; J.K = K; J.N = N; J.ldd = ldd; J.map = map; J.nbatch = nb; J.sbs = sbs; J.dbs = dbs; J.tile0 = t0; J.pad = 0;
        t0 += nb * (K / 128) * (N / 128);
    };
    for (int i = 0; i < 4; ++i) job(p.ffn_w_in + (size_t)i * DM * 2 * DFF, p.wt_in + (size_t)i * 2 * DFF * DM, 2 * DFF, DM, 2 * DFF, DM, 1, 1, 0, 0);
    for (int i = 0; i < 4; ++i) job(p.ffn_w_out + (size_t)i * DFF * DM, p.wt_out + (size_t)i * DM * DFF, DM, DFF, DM, DFF, 0, 1, 0, 0);
    job(p.ab_w_in, p.wt_ab, 6176, DM, 6144, DM, 0, 1, 0, 0);
    job(p.ab_w_out, p.wt_abo, DM, DM, DM, DM, 0, 1, 0, 0);
    job(p.c_w_in, p.wt_c, 3072, DM, 3072, DM, 2, 1, 0, 0);
    job(p.c_w_out, p.wt_co, DM, DM, DM, DM, 0, 1, 0, 0);
    job(p.cache_a_v, p.vta_s, 128, 512, 128, 2560, 0, 16, 512 * 128, 128 * 2560);
    job(p.cache_c_v, p.vtc_s, 128, 512, 128, 2560, 0, 8, 512 * 128, 128 * 2560);
    p.n_ttiles = t0;

    constexpr size_t kDynLds = pg8::STAGE_BYTES;
    static int grid_blocks = 0;
    if (!grid_blocks) {
        int dev = 0, cus = 0, per_cu = 0;
        hipGetDevice(&dev);
        hipDeviceGetAttribute(&cus, hipDeviceAttributeMultiprocessorCount, dev);
        hipFuncSetAttribute((const void*)fwd_megakernel, hipFuncAttributeMaxDynamicSharedMemorySize, (int)kDynLds);
        hipOccupancyMaxActiveBlocksPerMultiprocessor(&per_cu, fwd_megakernel, 512, kDynLds);
        if (per_cu < 1) per_cu = 1;
        grid_blocks = cus * 1;
    }
#if N_LAUNCH_SPLIT
    for (int ph = 0; ph < N_PHASES; ++ph) {
        p.phase_lo = ph; p.phase_hi = ph + 1;
        hipLaunchKernelGGL(fwd_megakernel, dim3(grid_blocks), dim3(512), kDynLds, stream, p);
    }
#else
    p.phase_lo = 0; p.phase_hi = 1 << 20;
    void* args[] = {&p};
    hipError_t e = hipLaunchCooperativeKernel((const void*)fwd_megakernel, dim3(grid_blocks), dim3(512), args, kDynLds, stream);
    if (e != hipSuccess) fprintf(stderr, "cooperative launch failed: %s (grid %d)\n", hipGetErrorString(e), grid_blocks);
#endif
}
```

```cpp
#include <hip/hip_runtime.h>
#include <hip/hip_cooperative_groups.h>
#include <stdint.h>
#include <string.h>
#include <stdio.h>
namespace cg = cooperative_groups;

typedef unsigned short bf16_t;
typedef short bf16x8 __attribute__((ext_vector_type(8)));
typedef float f32x4 __attribute__((ext_vector_type(4)));
typedef float f32x16 __attribute__((ext_vector_type(16)));
typedef unsigned u32x4 __attribute__((ext_vector_type(4)));
typedef unsigned u32x2 __attribute__((ext_vector_type(2)));
#define LAS __attribute__((address_space(3)))

#ifndef REP_PREP
#define REP_PREP 1
#endif
#ifndef REP_MIX0
#define REP_MIX0 1
#endif
#ifndef REP_MIX1
#define REP_MIX1 1
#endif
#ifndef REP_NORM
#define REP_NORM 1
#endif
#ifndef REP_FFNIN
#define REP_FFNIN 1
#endif
#ifndef REP_SYNC
#define REP_SYNC 1
#endif
#ifndef N_LAUNCH_SPLIT
#define N_LAUNCH_SPLIT 0
#endif

constexpr int NTOK = 8192, DM = 2048, DFF = 5632, NMODW = 18432;
constexpr float LOG2E = 1.4426950408889634f;
constexpr float LOG2_ROPE = 13.287712379549449f;

struct TJob { const float* src; bf16_t* dst; long long sbs, dbs; int lds, K, N, ldd, map, nbatch, tile0, pad; };

struct Params {
    const float *x_prompt, *x_sample, *cache_a_k, *cache_a_v, *state_f, *state_b, *cache_c_k, *cache_c_v, *c, *c_ctx;
    const float *ada_w, *ada_b, *norm_g, *ffn_w_in, *ffn_w_out, *ab_w_in, *ab_w_out, *a_lambda, *a_subln_g, *alpha_w, *alpha_b, *b_norm_g;
    const float *c_w_in, *c_w_out, *c_sink, *final_g;
    float *y, *new_a_k, *new_a_v, *new_b_f, *new_b_b, *new_c_k, *new_c_v;
    float* mods;
    float* xres;
    bf16_t* h;
    bf16_t* act;
    bf16_t* mo;
    bf16_t* wt_in;
    bf16_t* wt_out;
    bf16_t* wt_ab;
    bf16_t* wt_abo;
    bf16_t* wt_c;
    bf16_t* wt_co;
    bf16_t *qa_p, *ka_p, *vta_p;
    bf16_t *qa_s, *ka_s, *vta_s;
    bf16_t *qc_p, *kc_p, *vtc_p;
    bf16_t *qc_s, *kc_s, *vtc_s;
    bf16_t* pb;
    bf16_t* bvt;
    float* la;
    float* lacum;
    float *of, *ob;
    float* park;
    unsigned* bar;
    TJob jobs[14];
    int n_ttiles, phase_lo, phase_hi, pad0;
};

typedef const __attribute__((address_space(4))) Params CParams;

__device__ __forceinline__ unsigned f2bf(float f) { unsigned u = __float_as_uint(f); u += 0x7FFFu + ((u >> 16) & 1u); return u >> 16; }
__device__ __forceinline__ unsigned pk2(float lo, float hi) { return f2bf(lo) | (f2bf(hi) << 16); }
__device__ __forceinline__ float bf2f(bf16_t b) { return __uint_as_float(((unsigned)b) << 16); }
__device__ __forceinline__ float silu_f(float x) { return x / (1.0f + __expf(-x)); }
__device__ __forceinline__ int cond_of_row(int row) { return row < 4096 ? 0 : 1 + ((row - 4096) >> 11); }
__device__ __forceinline__ const float* modp(CParams& p, int kh, int l, int c) { return p.mods + (size_t)((kh * 2 + l) * 3 + c) * NMODW; }
__device__ __forceinline__ f32x4 mod4(CParams& p, int l, int c, int i, int col) {
    const f32x4 a = *(const f32x4*)(modp(p, 0, l, c) + i * DM + col), b = *(const f32x4*)(modp(p, 1, l, c) + i * DM + col);
    return a + b;
}
__device__ __forceinline__ f32x16 mfma32(bf16x8 a, bf16x8 b, f32x16 c) { return __builtin_amdgcn_mfma_f32_32x32x16_bf16(a, b, c, 0, 0, 0); }
__device__ __forceinline__ bf16x8 pack8(const f32x16& s, int base) {
    u32x4 r; r[0] = pk2(s[base + 0], s[base + 1]); r[1] = pk2(s[base + 2], s[base + 3]); r[2] = pk2(s[base + 4], s[base + 5]); r[3] = pk2(s[base + 6], s[base + 7]);
    return __builtin_bit_cast(bf16x8, r);
}
__device__ __forceinline__ float xor32(float v) { return __shfl_xor(v, 32, 64); }

namespace pg8 {
constexpr int BM = 256, BK = 64, HALF = 128, HTB = HALF * BK * 2, STAGE_BYTES = 8 * HTB, NXCD = 8, WGM = 8;
__device__ __forceinline__ int lds_byte(int r, int c) { const int st = (r >> 4) * 2 + (c >> 5), rr = r & 15, cc = c & 31, ob = rr * 64 + cc * 2; return st * 1024 + (ob ^ (((ob >> 9) & 1) << 5)); }
__device__ __forceinline__ void stage_rc(int b, int& R, int& C) { const int st = b / 1024, sb = b % 1024, swz = sb ^ (((sb >> 9) & 1) << 5); R = (st >> 1) * 16 + swz / 64; C = (st & 1) * 32 + (swz % 64) / 2; }
struct Unit { int pm, pn; };
struct Gemm { const bf16_t* A; const bf16_t* Bt; int M, N, K; };
struct StaticOrder {
    int nM, nN, nwg, G, c;
    __device__ void init(int M, int N, int G_, int c_) { nM = M / BM; nN = N / BM; nwg = nM * nN; G = G_; c = c_; }
    __device__ bool next(int i, Unit& u) const {
        const long L = (long)i * G + c; if (L >= nwg) return false;
        int wgid = (int)L; { const int q = nwg / NXCD, r = nwg % NXCD, xcd = wgid % NXCD, off = wgid / NXCD; wgid = (xcd < r ? xcd * (q + 1) : r * (q + 1) + (xcd - r) * q) + off; }
        const int nig = WGM * nN, gid = wgid / nig, fm = gid * WGM, gsz = (nM - fm) < WGM ? (nM - fm) : WGM;
        u.pm = fm + ((wgid % nig) % gsz); u.pn = (wgid % nig) / gsz; return true;
    }
};
template <class Epi>
__device__ __forceinline__ void gemm_phase(LAS unsigned char* lds, const Gemm g, const StaticOrder& S, const Epi& E) {
    const int tid = threadIdx.x, wid = __builtin_amdgcn_readfirstlane(tid >> 6), lane = tid & 63, wr = wid >> 2, wc = wid & 3, fr = lane & 15, fq = lane >> 4;
    const int K = g.K, nt = K / BK;
    unsigned voffA[2], voffB[2];
#pragma unroll
    for (int i = 0; i < 2; ++i) { int R, C; stage_rc(tid * 16 + i * 8192, R, C); voffA[i] = (unsigned)(R * K + C) * 2u; voffB[i] = voffA[i]; }
    const size_t kstep = (size_t)(BK * 2);
    const size_t hstep = (size_t)HALF * K * 2;
    const size_t tstep = 2 * hstep;
    const unsigned ldsw = (unsigned)wid * 1024u;
    const int aoff = lds_byte(wr * 64 + fr, fq * 8), boff = lds_byte(wc * 32 + fr, fq * 8);
#define PG8_SA(b, h) (((b) * 2 + (h)) * HTB)
#define PG8_SB(b, h) ((4 + (b) * 2 + (h)) * HTB)
#define PG8_STAGE(bufoff, gbase, voff) do { _Pragma("unroll") for (int _i = 0; _i < 2; ++_i) \
        __builtin_amdgcn_global_load_lds((const unsigned*)((const char*)(gbase) + (voff)[_i]), (LAS unsigned*)(lds + (bufoff) + ldsw + _i * 8192), 16, 0, 0); } while (0)
#define PG8_LDA(dst, b, h) do { _Pragma("unroll") for (int m = 0; m < 4; ++m) _Pragma("unroll") for (int k = 0; k < 2; ++k) dst[m][k] = *(const LAS bf16x8*)(lds + PG8_SA(b, h) + aoff + m * 2048 + k * 1024); } while (0)
#define PG8_LDB(dst, b, h) do { _Pragma("unroll") for (int n = 0; n < 2; ++n) _Pragma("unroll") for (int k = 0; k < 2; ++k) dst[n][k] = *(const LAS bf16x8*)(lds + PG8_SB(b, h) + boff + n * 2048 + k * 1024); } while (0)
#define PG8_MMA(ai, bj, At, Bt) do { __builtin_amdgcn_s_setprio(1); _Pragma("unroll") for (int m = 0; m < 4; ++m) _Pragma("unroll") for (int n = 0; n < 2; ++n) _Pragma("unroll") for (int k = 0; k < 2; ++k) \
        acc[ai][bj][m][n] = __builtin_amdgcn_mfma_f32_16x16x32_bf16(Bt[n][k], At[m][k], acc[ai][bj][m][n], 0, 0, 0); __builtin_amdgcn_s_setprio(0); } while (0)
#define PG8_WAIT_V(n) asm volatile("s_waitcnt vmcnt(" #n ")" ::: "memory")
#define PG8_WAIT_L(n) asm volatile("s_waitcnt lgkmcnt(" #n ")" ::: "memory")
#define PG8_BAR __builtin_amdgcn_s_barrier()
#define PG8_SCHED __builtin_amdgcn_sched_barrier(0)
    Unit cur, nxt; int ui = 0;
    if (!S.next(0, cur)) return;
    f32x4 acc[2][2][4][2];
#pragma unroll
    for (int a = 0; a < 2; ++a)
#pragma unroll
        for (int b = 0; b < 2; ++b)
#pragma unroll
            for (int m = 0; m < 4; ++m)
#pragma unroll
                for (int n = 0; n < 2; ++n) acc[a][b][m][n] = (f32x4){0.f, 0.f, 0.f, 0.f};
    bf16x8 At[4][2], B0[2][2], B1[2][2];
    const char* cA = (const char*)g.A + (size_t)cur.pm * tstep; const char* cB = (const char*)g.Bt + (size_t)cur.pn * tstep;
    PG8_STAGE(PG8_SB(0, 0), cB, voffB); PG8_STAGE(PG8_SA(0, 0), cA, voffA); PG8_STAGE(PG8_SB(0, 1), cB + hstep, voffB); PG8_STAGE(PG8_SA(0, 1), cA + hstep, voffA);
    if (wr == 1) PG8_BAR;
    PG8_WAIT_V(4); PG8_BAR;
    PG8_STAGE(PG8_SB(1, 0), cB + kstep, voffB); PG8_STAGE(PG8_SA(1, 0), cA + kstep, voffA); PG8_STAGE(PG8_SB(1, 1), cB + hstep + kstep, voffB);
    PG8_WAIT_V(6); PG8_BAR;
    for (;;) {
        const bool has_next = S.next(ui + 1, nxt);
        const char* nA = has_next ? (const char*)g.A + (size_t)nxt.pm * tstep : cA; const char* nB = has_next ? (const char*)g.Bt + (size_t)nxt.pn * tstep : cB;
        for (int t = 0; t < nt; t += 2) {
            const bool last = (t == nt - 2);
            const char* a1 = cA + (size_t)(t + 1) * kstep;
            const char* a2 = last ? nA : cA + (size_t)(t + 2) * kstep; const char* b2 = last ? nB : cB + (size_t)(t + 2) * kstep;
            const char* a3 = a2 + kstep; const char* b3 = b2 + kstep;
            PG8_LDB(B0, 0, 0); PG8_SCHED; PG8_LDA(At, 0, 0); PG8_STAGE(PG8_SA(1, 1), a1 + hstep, voffA);
            PG8_WAIT_L(8); PG8_BAR; PG8_WAIT_L(0); PG8_MMA(0, 0, At, B0); PG8_BAR; PG8_SCHED;
            PG8_LDB(B1, 0, 1); PG8_STAGE(PG8_SB(0, 0), b2, voffB);
            PG8_BAR; PG8_WAIT_L(0); PG8_MMA(0, 1, At, B1); PG8_BAR;
            PG8_LDA(At, 0, 1); PG8_STAGE(PG8_SA(0, 0), a2, voffA);
            PG8_BAR; PG8_WAIT_L(0); PG8_MMA(1, 0, At, B0); PG8_BAR; PG8_SCHED;
            PG8_STAGE(PG8_SB(0, 1), b2 + hstep, voffB);
            PG8_WAIT_V(6); PG8_BAR; PG8_MMA(1, 1, At, B1); PG8_BAR;
            PG8_LDB(B0, 1, 0); PG8_SCHED; PG8_LDA(At, 1, 0); PG8_STAGE(PG8_SA(0, 1), a2 + hstep, voffA);
            PG8_WAIT_L(8); PG8_BAR; PG8_WAIT_L(0); PG8_MMA(0, 0, At, B0); PG8_BAR; PG8_SCHED;
            PG8_LDB(B1, 1, 1); PG8_STAGE(PG8_SB(1, 0), b3, voffB);
            PG8_BAR; PG8_WAIT_L(0); PG8_MMA(0, 1, At, B1); PG8_BAR;
            PG8_LDA(At, 1, 1); PG8_STAGE(PG8_SA(1, 0), a3, voffA);
            PG8_BAR; PG8_WAIT_L(0); PG8_MMA(1, 0, At, B0); PG8_BAR; PG8_SCHED;
            PG8_STAGE(PG8_SB(1, 1), b3 + hstep, voffB);
            PG8_WAIT_V(6); PG8_BAR; PG8_MMA(1, 1, At, B1); PG8_BAR;
        }
        E(acc, cur, wr, wc, fr, fq);
        if (!has_next) break;
#pragma unroll
        for (int a = 0; a < 2; ++a)
#pragma unroll
            for (int b = 0; b < 2; ++b)
#pragma unroll
                for (int m = 0; m < 4; ++m)
#pragma unroll
                    for (int n = 0; n < 2; ++n) acc[a][b][m][n] = (f32x4){0.f, 0.f, 0.f, 0.f};
        cur = nxt; cA = nA; cB = nB; ++ui;
    }
    PG8_WAIT_V(0);
    if (wr == 0) PG8_BAR;
    PG8_BAR;
#undef PG8_SA
#undef PG8_SB
#undef PG8_STAGE
#undef PG8_LDA
#undef PG8_LDB
#undef PG8_MMA
#undef PG8_WAIT_V
#undef PG8_WAIT_L
#undef PG8_BAR
#undef PG8_SCHED
}
}
using pg8::Unit;
typedef f32x4 Acc[2][2][4][2];

struct EpiSwiGLU {
    bf16_t* act;
    __device__ __forceinline__ void operator()(const Acc& acc, const Unit& u, int wr, int wc, int fr, int fq) const {
#pragma unroll
        for (int ai = 0; ai < 2; ++ai)
#pragma unroll
            for (int m = 0; m < 4; ++m) {
                const int row = u.pm * 256 + ai * 128 + wr * 64 + m * 16 + fr;
                bf16_t* rp = act + (size_t)row * DFF + u.pn * 128 + wc * 32 + 4 * fq;
#pragma unroll
                for (int n = 0; n < 2; ++n) {
                    const f32x4 g = acc[ai][0][m][n], up = acc[ai][1][m][n];
                    u32x2 o; o[0] = pk2(silu_f(g[0]) * up[0], silu_f(g[1]) * up[1]); o[1] = pk2(silu_f(g[2]) * up[2], silu_f(g[3]) * up[3]);
                    *(u32x2*)(rp + 16 * n) = o;
                }
            }
    }
};
struct EpiResid {
    CParams* p; int l, gi; float gs;
    __device__ __forceinline__ void operator()(const Acc& acc, const Unit& u, int wr, int wc, int fr, int fq) const {
        const int cond = cond_of_row(u.pm * 256);
        f32x4 gt[2][2];
#pragma unroll
        for (int bj = 0; bj < 2; ++bj)
#pragma unroll
            for (int n = 0; n < 2; ++n) gt[bj][n] = mod4(*p, l, cond, gi, u.pn * 256 + bj * 128 + wc * 32 + 16 * n + 4 * fq) * gs;
#pragma unroll
        for (int ai = 0; ai < 2; ++ai)
#pragma unroll
            for (int m = 0; m < 4; ++m) {
                const int row = u.pm * 256 + ai * 128 + wr * 64 + m * 16 + fr;
                float* rp = p->xres + (size_t)row * DM + u.pn * 256 + wc * 32 + 4 * fq;
#pragma unroll
                for (int bj = 0; bj < 2; ++bj)
#pragma unroll
                    for (int n = 0; n < 2; ++n) { f32x4* q = (f32x4*)(rp + bj * 128 + 16 * n); *q = *q + gt[bj][n] * acc[ai][bj][m][n]; }
            }
    }
};
__device__ __forceinline__ void rope4(f32x4& x1, f32x4& x2, float pos, int i0, float expo_scale) {
#pragma unroll
    for (int j = 0; j < 4; ++j) {
        const float inv = __builtin_amdgcn_exp2f(-LOG2_ROPE * expo_scale * (float)(i0 + j));
        const float ang = pos * inv, cs = __cosf(ang), sn = __sinf(ang);
        const float a = x1[j], b = x2[j];
        x1[j] = a * cs - b * sn; x2[j] = a * sn + b * cs;
    }
}
__device__ __forceinline__ void st4bf(bf16_t* dst, const f32x4& v) { u32x2 o; o[0] = pk2(v[0], v[1]); o[1] = pk2(v[2], v[3]); *(u32x2*)dst = o; }
struct EpiAB {
    CParams* p;
    __device__ __forceinline__ void operator()(const Acc& acc, const Unit& u, int wr, int wc, int fr, int fq) const {
        CParams& P = *p;
#pragma unroll
        for (int bj = 0; bj < 2; ++bj) {
            const int cb = u.pn * 256 + bj * 128;
#pragma unroll
            for (int ai = 0; ai < 2; ++ai)
#pragma unroll
                for (int m = 0; m < 4; ++m) {
                    const int row = u.pm * 256 + ai * 128 + wr * 64 + m * 16 + fr;
                    f32x4 v0 = acc[ai][bj][m][0], v1 = acc[ai][bj][m][1];
                    const bool lat = row >= 4096;
                    const int b = row >> 8, pos = row & 255, ts = row - 4096, bs = ts >> 11, tt = ts & 2047;
                    if (cb < 3072) {
                        const int which = cb >> 10, hh = (cb & 1023) >> 7, d0 = wc * 32 + 4 * fq;
                        if (which < 2 && lat) rope4(v0, v1, (wc & 1) ? (float)(tt & 63) : (float)(tt >> 6), 4 * fq, 1.0f / 16.0f);
                        if (which == 0) {
                            v0 = v0 * (0.125f * LOG2E); v1 = v1 * (0.125f * LOG2E);
                            bf16_t* q = lat ? P.qa_s + ((size_t)(bs * 8 + hh) * 2048 + tt) * 128 : P.qa_p + ((size_t)(b * 8 + hh) * 256 + pos) * 128;
                            st4bf(q + d0, v0); st4bf(q + d0 + 16, v1);
                        } else if (which == 1) {
                            bf16_t* q = lat ? P.ka_s + ((size_t)(bs * 8 + hh) * 2560 + 512 + tt) * 128 : P.ka_p + ((size_t)(b * 8 + hh) * 256 + pos) * 128;
                            st4bf(q + d0, v0); st4bf(q + d0 + 16, v1);
                            if (!lat) { float* o = P.new_a_k + ((size_t)(b * 8 + hh) * 256 + pos) * 128 + d0; *(f32x4*)o = v0; *(f32x4*)(o + 16) = v1; }
                        } else {
                            bf16_t* q; int ld;
                            if (lat) { q = P.vta_s + (size_t)(bs * 8 + hh) * 128 * 2560 + 512 + tt; ld = 2560; } else { q = P.vta_p + (size_t)(b * 8 + hh) * 128 * 256 + pos; ld = 256; }
#pragma unroll
                            for (int j = 0; j < 4; ++j) { q[(size_t)(d0 + j) * ld] = (bf16_t)f2bf(v0[j]); q[(size_t)(d0 + 16 + j) * ld] = (bf16_t)f2bf(v1[j]); }
                            if (!lat) { float* o = P.new_a_v + ((size_t)(b * 8 + hh) * 256 + pos) * 128 + d0; *(f32x4*)o = v0; *(f32x4*)(o + 16) = v1; }
                        }
                    } else if (cb < 6144) {
                        const int c0 = cb - 3072 + wc * 32 + 4 * fq;
                        if (cb < 3584) { v0 = v0 * 0.08838834764831845f; v1 = v1 * 0.08838834764831845f; }
                        if (cb >= 4096 && cb < 5120) {
                            bf16_t* q = P.bvt + (size_t)(c0 - 1024) * NTOK + row;
#pragma unroll
                            for (int j = 0; j < 4; ++j) { q[(size_t)j * NTOK] = (bf16_t)f2bf(v0[j]); q[(size_t)(16 + j) * NTOK] = (bf16_t)f2bf(v1[j]); }
                        } else {
                            if (cb >= 5120) {
#pragma unroll
                                for (int j = 0; j < 4; ++j) { v0[j] = silu_f(v0[j]); v1[j] = silu_f(v1[j]); }
                            }
                            bf16_t* q = P.pb + (size_t)row * 3072 + c0;
                            st4bf(q, v0); st4bf(q + 16, v1);
                        }
                    } else {
                        const int c0 = cb - 6144 + wc * 32 + 4 * fq;
                        const f32x4 b0 = *(const f32x4*)(P.alpha_b + c0), b1 = *(const f32x4*)(P.alpha_b + c0 + 16);
#pragma unroll
                        for (int j = 0; j < 4; ++j) {
                            float x = v0[j] + b0[j]; v0[j] = (fminf(x, 0.f) - __logf(1.0f + __expf(-fabsf(x)))) * (1.0f / 16.0f);
                            x = v1[j] + b1[j];       v1[j] = (fminf(x, 0.f) - __logf(1.0f + __expf(-fabsf(x)))) * (1.0f / 16.0f);
                        }
                        float* q = P.la + (size_t)row * 1024 + c0;
                        *(f32x4*)q = v0; *(f32x4*)(q + 16) = v1;
                    }
                }
        }
    }
};
struct EpiC {
    CParams* p;
    __device__ __forceinline__ void operator()(const Acc& acc, const Unit& u, int wr, int wc, int fr, int fq) const {
        CParams& P = *p;
#pragma unroll
        for (int bj = 0; bj < 2; ++bj) {
            const int cb = u.pn * 256 + bj * 128;
#pragma unroll
            for (int ai = 0; ai < 2; ++ai)
#pragma unroll
                for (int m = 0; m < 4; ++m) {
                    const int row = u.pm * 256 + ai * 128 + wr * 64 + m * 16 + fr;
                    f32x4 v0 = acc[ai][bj][m][0], v1 = acc[ai][bj][m][1];
                    const bool lat = row >= 4096;
                    const int b = row >> 8, pos = row & 255, ts = row - 4096, bs = ts >> 11, tt = ts & 2047;
                    if (cb < 2560) {
                        const int gidx = wc >> 1, i0 = 16 * (wc & 1) + 4 * fq, d1 = 64 * gidx + i0;
                        if (lat) rope4(v0, v1, gidx ? (float)(tt & 63) : (float)(tt >> 6), i0, 1.0f / 32.0f);
                        if (cb < 2048) {
                            const int hh = cb >> 7;
                            v0 = v0 * (0.08838834764831845f * LOG2E); v1 = v1 * (0.08838834764831845f * LOG2E);
                            bf16_t* q = lat ? P.qc_s + ((size_t)(bs * 16 + hh) * 2048 + tt) * 128 : P.qc_p + ((size_t)(b * 16 + hh) * 256 + pos) * 128;
                            st4bf(q + d1, v0); st4bf(q + d1 + 32, v1);
                        } else {
                            const int kv = (cb - 2048) >> 7;
                            bf16_t* q = lat ? P.kc_s + ((size_t)(bs * 4 + kv) * 2560 + 512 + tt) * 128 : P.kc_p + ((size_t)(b * 4 + kv) * 256 + pos) * 128;
                            st4bf(q + d1, v0); st4bf(q + d1 + 32, v1);
                            if (!lat) { float* o = P.new_c_k + ((size_t)(b * 4 + kv) * 256 + pos) * 128 + d1; *(f32x4*)o = v0; *(f32x4*)(o + 32) = v1; }
                        }
                    } else {
                        const int kv = (cb - 2560) >> 7, d0 = wc * 32 + 4 * fq;
                        bf16_t* q; int ld;
                        if (lat) { q = P.vtc_s + (size_t)(bs * 4 + kv) * 128 * 2560 + 512 + tt; ld = 2560; } else { q = P.vtc_p + (size_t)(b * 4 + kv) * 128 * 256 + pos; ld = 256; }
#pragma unroll
                        for (int j = 0; j < 4; ++j) { q[(size_t)(d0 + j) * ld] = (bf16_t)f2bf(v0[j]); q[(size_t)(d0 + 16 + j) * ld] = (bf16_t)f2bf(v1[j]); }
                        if (!lat) { float* o = P.new_c_v + ((size_t)(b * 4 + kv) * 256 + pos) * 128 + d0; *(f32x4*)o = v0; *(f32x4*)(o + 16) = v1; }
                    }
                }
        }
    }
};

__device__ __forceinline__ int colmap(int map, int n) {
    if (map == 1) { const int t = n >> 8, w = n & 255; return (w < 128) ? t * 128 + w : DFF + t * 128 + (w - 128); }
    if (map == 2) { if (n >= 2560) return n; const int p = n & 63, i = (p >> 5) * 16 + (p & 15), s = (p >> 4) & 1; return (n & ~63) + i + 32 * s; }
    return n;
}
template <class JobT>
__device__ __forceinline__ void transpose_tile(const JobT& J, int tl) {
    const int tid = threadIdx.x, wave = tid >> 6, lane = tid & 63;
    const int nkt = J.K >> 7, nnt = J.N >> 7;
    const int kt = tl % nkt, r = tl / nkt, nt = r % nnt, b = r / nnt;
    const float* src = J.src + (size_t)b * J.sbs; bf16_t* dst = J.dst + (size_t)b * J.dbs;
    const int nsub = wave & 3, ksub = wave >> 2, kg = lane >> 3, c4 = lane & 7;
    const int n = nt * 128 + nsub * 32 + c4 * 4, k = kt * 128 + ksub * 64 + kg * 8;
    const int sc = colmap(J.map, n);
    f32x4 v[8];
#pragma unroll
    for (int i = 0; i < 8; ++i) v[i] = *(const f32x4*)(src + (size_t)(k + i) * J.lds + sc);
#pragma unroll
    for (int e = 0; e < 4; ++e) {
        u32x4 o; o[0] = pk2(v[0][e], v[1][e]); o[1] = pk2(v[2][e], v[3][e]); o[2] = pk2(v[4][e], v[5][e]); o[3] = pk2(v[6][e], v[7][e]);
        *(u32x4*)(dst + (size_t)(n + e) * J.ldd + k) = o;
    }
}
constexpr int IT_ADA = 288, IT_XCP = 1024, IT_CK = 384, IT_WEFF = 128;
__device__ __forceinline__ void phase_prep(CParams& P, LAS unsigned char* lds) {
    const int tid = threadIdx.x, wave = tid >> 6, lane = tid & 63;
    const int total = IT_ADA + IT_XCP + IT_CK + IT_WEFF + P.n_ttiles;
    LAS float* sc = (LAS float*)lds;
    LAS float* red = (LAS float*)(lds + 12288);
    for (int it = blockIdx.x; it < total; it += gridDim.x) {
        if (it < IT_ADA) {
            const int l = it / 144, r = it % 144, strip = r >> 1, kh = r & 1;
            for (int i = tid; i < 3072; i += 512) { const int c = i >> 10, k = kh * 1024 + (i & 1023); const float x = (c == 0) ? P.c_ctx[k] : P.c[(c - 1) * DM + k]; sc[i] = silu_f(x); }
            __syncthreads();
            const int kl0 = wave * 128;
            const float* W = P.ada_w + ((size_t)l * DM + kh * 1024 + kl0) * NMODW + strip * 256 + lane * 4;
            f32x4 a0 = {0, 0, 0, 0}, a1 = a0, a2 = a0;
#pragma unroll 8
            for (int k = 0; k < 128; ++k) {
                const f32x4 w = *(const f32x4*)(W + (size_t)k * NMODW);
                a0 += w * sc[kl0 + k]; a1 += w * sc[1024 + kl0 + k]; a2 += w * sc[2048 + kl0 + k];
            }
            *(LAS f32x4*)(red + (wave * 3 + 0) * 256 + lane * 4) = a0; *(LAS f32x4*)(red + (wave * 3 + 1) * 256 + lane * 4) = a1; *(LAS f32x4*)(red + (wave * 3 + 2) * 256 + lane * 4) = a2;
            __syncthreads();
            if (tid < 256) {
                const int col = strip * 256 + tid;
                const float bias = kh == 0 ? P.ada_b[(size_t)l * NMODW + col] : 0.f;
#pragma unroll
                for (int c = 0; c < 3; ++c) { float s = bias; for (int w = 0; w < 8; ++w) s += red[(w * 3 + c) * 256 + tid]; ((float*)modp(P, kh, l, c))[col] = s; }
            }
            __syncthreads();
        } else if (it < IT_ADA + IT_XCP) {
            const int j = it - IT_ADA;
#pragma unroll
            for (int i = 0; i < 8; ++i) {
                const size_t e = (size_t)j * 16384 + (size_t)(i * 512 + tid) * 4;
                const float* s = e < (size_t)4096 * DM ? P.x_prompt + e : P.x_sample + (e - (size_t)4096 * DM);
                *(f32x4*)(P.xres + e) = *(const f32x4*)s;
            }
        } else if (it < IT_ADA + IT_XCP + IT_CK) {
            const int j = it - IT_ADA - IT_XCP;
            const bool isa = j < 256; const int jj = isa ? j : j - 256;
            const float* s = isa ? P.cache_a_k : P.cache_c_k; bf16_t* d = isa ? P.ka_s : P.kc_s;
            const size_t e = (size_t)jj * 4096 + (size_t)tid * 8;
            const size_t bh = e >> 16, rem = e & 65535;
            const f32x4 v0 = *(const f32x4*)(s + e), v1 = *(const f32x4*)(s + e + 4);
            u32x4 o; o[0] = pk2(v0[0], v0[1]); o[1] = pk2(v0[2], v0[3]); o[2] = pk2(v1[0], v1[1]); o[3] = pk2(v1[2], v1[3]);
            *(u32x4*)(d + bh * (size_t)(2560 * 128) + rem) = o;
        } else if (it < IT_ADA + IT_XCP + IT_CK + IT_WEFF) {
            const int j = it - IT_ADA - IT_XCP - IT_CK;
            const int dir = (j * 8) >> 9;
            for (int kk = 0; kk < 4; ++kk) {
                const int k = tid + 512 * kk;
                float wl[16];
#pragma unroll
                for (int q = 0; q < 4; ++q) { const f32x4 t = *(const f32x4*)(P.ab_w_in + (size_t)k * 6176 + 6144 + 16 * dir + 4 * q); wl[4 * q] = t[0]; wl[4 * q + 1] = t[1]; wl[4 * q + 2] = t[2]; wl[4 * q + 3] = t[3]; }
#pragma unroll
                for (int jj = 0; jj < 8; ++jj) {
                    const int n = (j * 8 + jj) & 511; float s = 0.f;
#pragma unroll
                    for (int r = 0; r < 16; ++r) s += wl[r] * P.alpha_w[(size_t)(dir * 16 + r) * 512 + n];
                    P.wt_ab[(size_t)(6144 + j * 8 + jj) * DM + k] = (bf16_t)f2bf(s);
                }
            }
        } else {
            const int tl = it - (IT_ADA + IT_XCP + IT_CK + IT_WEFF);
            int ji = 0;
            for (int q = 1; q < 14; ++q) if (tl >= P.jobs[q].tile0) ji = q;
            transpose_tile(P.jobs[ji], tl - P.jobs[ji].tile0);
        }
    }
}

__device__ __forceinline__ void phase_norm(CParams& P, int l, int which, int si) {
    const int tid = threadIdx.x, wave = tid >> 6, lane = tid & 63;
    const float* g = P.norm_g + (size_t)(l * 3 + which) * DM;
    for (int row = blockIdx.x * 8 + wave; row < NTOK; row += gridDim.x * 8) {
        const float* xp = P.xres + (size_t)row * DM;
        const int cond = cond_of_row(row);
        f32x4 v[8]; float ss = 0.f;
#pragma unroll
        for (int i = 0; i < 8; ++i) { v[i] = *(const f32x4*)(xp + 4 * lane + 256 * i); ss += v[i][0] * v[i][0] + v[i][1] * v[i][1] + v[i][2] * v[i][2] + v[i][3] * v[i][3]; }
#pragma unroll
        for (int o = 32; o >= 1; o >>= 1) ss += __shfl_xor(ss, o, 64);
        const float rstd = rsqrtf(ss * (1.0f / DM) + 1e-6f);
#pragma unroll
        for (int i = 0; i < 8; ++i) {
            const int col = 4 * lane + 256 * i;
            const f32x4 gg = *(const f32x4*)(g + col), sh = mod4(P, l, cond, si, col), scl = mod4(P, l, cond, si + 1, col);
            const f32x4 y = (v[i] * rstd) * gg * (scl + 1.0f) + sh;
            st4bf(P.h + (size_t)row * DM + col, y);
        }
    }
}
__device__ __forceinline__ void phase_final_norm(CParams& P) {
    const int tid = threadIdx.x, wave = tid >> 6, lane = tid & 63;
    for (int row = blockIdx.x * 8 + wave; row < NTOK; row += gridDim.x * 8) {
        const float* xp = P.xres + (size_t)row * DM;
        f32x4 v[8]; float ss = 0.f;
#pragma unroll
        for (int i = 0; i < 8; ++i) { v[i] = *(const f32x4*)(xp + 4 * lane + 256 * i); ss += v[i][0] * v[i][0] + v[i][1] * v[i][1] + v[i][2] * v[i][2] + v[i][3] * v[i][3]; }
#pragma unroll
        for (int o = 32; o >= 1; o >>= 1) ss += __shfl_xor(ss, o, 64);
        const float rstd = rsqrtf(ss * (1.0f / DM) + 1e-6f);
#pragma unroll
        for (int i = 0; i < 8; ++i) { const int col = 4 * lane + 256 * i; *(f32x4*)(P.y + (size_t)row * DM + col) = (v[i] * rstd) * *(const f32x4*)(P.final_g + col); }
    }
}
__device__ __forceinline__ void phase_gla_merge(CParams& P) {
    const int tid = threadIdx.x, wave = tid >> 6, lane = tid & 63;
    for (int it = blockIdx.x * 8 + wave; it < NTOK * 4; it += gridDim.x * 8) {
        const int row = it >> 2, hh = it & 3, col = hh * 256 + 4 * lane;
        const f32x4 a = *(const f32x4*)(P.of + (size_t)row * 1024 + col) + *(const f32x4*)(P.ob + (size_t)row * 1024 + col);
        float ss = a[0] * a[0] + a[1] * a[1] + a[2] * a[2] + a[3] * a[3];
#pragma unroll
        for (int o = 32; o >= 1; o >>= 1) ss += __shfl_xor(ss, o, 64);
        const float rstd = rsqrtf(ss * (1.0f / 256.0f) + 1e-6f);
        const f32x4 g = *(const f32x4*)(P.b_norm_g + 4 * lane);
        const u32x2 br = *(const u32x2*)(P.pb + (size_t)row * 3072 + 2048 + col);
        f32x4 r; r[0] = __uint_as_float(br[0] << 16); r[1] = __uint_as_float(br[0] & 0xffff0000u); r[2] = __uint_as_float(br[1] << 16); r[3] = __uint_as_float(br[1] & 0xffff0000u);
        st4bf(P.mo + (size_t)row * DM + 1024 + col, a * rstd * g * r);
    }
}

constexpr int KS_BYTES = 64 * 136 * 2, VS_BYTES = 128 * 72 * 2, VS_OFF = 2 * KS_BYTES;
template <int DQ>
__device__ __forceinline__ void attn_pass(LAS unsigned char* lds, const bf16_t* Qw, int ldq, const bf16_t* Kb, int ldk, const bf16_t* Vt, int ldv,
                                          int nt, int t_band0, int kidx_band0, int kp_band0, int qpos, int qw0,
                                          float m0, float l0, f32x16 (&o)[4], float& l_out) {
    const int tid = threadIdx.x, lane = tid & 63, h = lane >> 5, r31 = lane & 31;
    constexpr int KROW = DQ + 8, KCH = DQ / 8, NKC = (64 * KCH) / 512;
    bf16x8 qf[DQ / 16];
#pragma unroll
    for (int ks = 0; ks < DQ / 16; ++ks) qf[ks] = *(const bf16x8*)(Qw + (size_t)r31 * ldq + 16 * ks + 8 * h);
#pragma unroll
    for (int dt = 0; dt < 4; ++dt)
#pragma unroll
        for (int i = 0; i < 16; ++i) o[dt][i] = 0.f;
    float m = m0, l = l0;
    u32x4 kreg[NKC], vreg[2];
    auto kidx_of = [&](int t) { return t < t_band0 ? 64 * t : kidx_band0 + 64 * (t - t_band0); };
    auto load_regs = [&](int t) {
        const int k0 = kidx_of(t);
#pragma unroll
        for (int i = 0; i < NKC; ++i) { const int c = tid + 512 * i, key = c / KCH, ch = c % KCH; kreg[i] = *(const u32x4*)(Kb + (size_t)(k0 + key) * ldk + 8 * ch); }
#pragma unroll
        for (int i = 0; i < 2; ++i) { const int c = tid + 512 * i, d = c >> 3, ch = c & 7; vreg[i] = *(const u32x4*)(Vt + (size_t)d * ldv + k0 + 8 * ch); }
    };
    auto store_lds = [&](int buf) {
#pragma unroll
        for (int i = 0; i < NKC; ++i) { const int c = tid + 512 * i, key = c / KCH, ch = c % KCH; *(LAS u32x4*)(lds + buf * KS_BYTES + (key * KROW + 8 * ch) * 2) = kreg[i]; }
#pragma unroll
        for (int i = 0; i < 2; ++i) { const int c = tid + 512 * i, d = c >> 3, ch = c & 7; *(LAS u32x4*)(lds + VS_OFF + buf * VS_BYTES + (d * 72 + 8 * ch) * 2) = vreg[i]; }
    };
    __syncthreads();
    load_regs(0); store_lds(0);
    __syncthreads();
    for (int t = 0; t < nt; ++t) {
        const int buf = t & 1;
        if (t + 1 < nt) load_regs(t + 1);
        const bool band = t >= t_band0;
        const int kp0 = kp_band0 + 64 * (t - t_band0);
        const bool skip = band && (kp0 > qw0 + 31 + 128 || kp0 + 63 < qw0 - 128);
        if (!skip) {
            f32x16 s[2];
#pragma unroll
            for (int kt = 0; kt < 2; ++kt) {
#pragma unroll
                for (int i = 0; i < 16; ++i) s[kt][i] = 0.f;
#pragma unroll
                for (int ks = 0; ks < DQ / 16; ++ks) {
                    const bf16x8 a = *(const LAS bf16x8*)(lds + buf * KS_BYTES + ((kt * 32 + r31) * KROW + 16 * ks + 8 * h) * 2);
                    s[kt] = mfma32(a, qf[ks], s[kt]);
                }
            }
            if (band) {
#pragma unroll
                for (int kt = 0; kt < 2; ++kt)
#pragma unroll
                    for (int i = 0; i < 16; ++i) { const int kp = kp0 + 32 * kt + (i & 3) + 8 * (i >> 2) + 4 * h; const int dlt = qpos - kp; if (dlt > 128 || dlt < -128) s[kt][i] = -1e30f; }
            }
            float mx = s[0][0];
#pragma unroll
            for (int kt = 0; kt < 2; ++kt)
#pragma unroll
                for (int i = 0; i < 16; ++i) mx = fmaxf(mx, s[kt][i]);
            mx = fmaxf(mx, xor32(mx));
            const float mn = fmaxf(m, mx), alpha = __builtin_amdgcn_exp2f(m - mn);
            m = mn;
            float ps = 0.f;
#pragma unroll
            for (int kt = 0; kt < 2; ++kt)
#pragma unroll
                for (int i = 0; i < 16; ++i) { const float pv = __builtin_amdgcn_exp2f(s[kt][i] - mn); s[kt][i] = pv; ps += pv; }
            l = l * alpha + ps;
#pragma unroll
            for (int dt = 0; dt < 4; ++dt)
#pragma unroll
                for (int i = 0; i < 16; ++i) o[dt][i] *= alpha;
            bf16x8 pb[2][2];
#pragma unroll
            for (int kt = 0; kt < 2; ++kt) { pb[kt][0] = pack8(s[kt], 0); pb[kt][1] = pack8(s[kt], 8); }
#pragma unroll
            for (int dt = 0; dt < 4; ++dt)
#pragma unroll
                for (int kt = 0; kt < 2; ++kt)
#pragma unroll
                    for (int s2 = 0; s2 < 2; ++s2) {
                        const LAS unsigned char* vp = lds + VS_OFF + buf * VS_BYTES + ((dt * 32 + r31) * 72 + 32 * kt + 16 * s2 + 4 * h) * 2;
                        const u32x2 lo = *(const LAS u32x2*)vp, hi = *(const LAS u32x2*)(vp + 16);
                        u32x4 av; av[0] = lo[0]; av[1] = lo[1]; av[2] = hi[0]; av[3] = hi[1];
                        o[dt] = mfma32(__builtin_bit_cast(bf16x8, av), pb[kt][s2], o[dt]);
                    }
        }
        if (t + 1 < nt) store_lds(buf ^ 1);
        __syncthreads();
    }
    l_out = l + xor32(l);
}

__device__ __forceinline__ void diff_attn_item(CParams& P, LAS unsigned char* lds, int item, float lam, float lam_init) {
    const int tid = threadIdx.x, wave = tid >> 6, lane = tid & 63, h = lane >> 5, r31 = lane & 31;
    const bf16_t *Q, *K, *Vt; int nk, row0;
    if (item < 128) { const int bh = item >> 3, qt = item & 7; Q = P.qa_s + ((size_t)bh * 2048 + qt * 256) * 128; K = P.ka_s + (size_t)bh * 2560 * 128; Vt = P.vta_s + (size_t)bh * 128 * 2560; nk = 2560; row0 = 4096 + (bh >> 3) * 2048 + qt * 256; }
    else { const int bh = item - 128; Q = P.qa_p + (size_t)bh * 256 * 128; K = P.ka_p + (size_t)bh * 256 * 128; Vt = P.vta_p + (size_t)bh * 128 * 256; nk = 256; row0 = (bh >> 3) * 256; }
    const int hh = (item < 128 ? (item >> 3) : (item - 128)) & 7;
    f32x16 o1[4]; float l1, l2;
    f32x4* park = (f32x4*)P.park + (size_t)blockIdx.x * 16 * 512 + tid;
    attn_pass<64>(lds, Q + (size_t)(wave * 32) * 128, 128, K, 128, Vt, nk, nk / 64, nk / 64, 0, 0, 0, 0, -1e30f, 0.f, o1, l1);
    {
        const float i1 = 1.0f / l1;
#pragma unroll
        for (int dt = 0; dt < 4; ++dt)
#pragma unroll
            for (int g = 0; g < 4; ++g) { f32x4 v; v[0] = o1[dt][4 * g] * i1; v[1] = o1[dt][4 * g + 1] * i1; v[2] = o1[dt][4 * g + 2] * i1; v[3] = o1[dt][4 * g + 3] * i1; park[(dt * 4 + g) * 512] = v; }
    }
    attn_pass<64>(lds, Q + (size_t)(wave * 32) * 128 + 64, 128, K + 64, 128, Vt, nk, nk / 64, nk / 64, 0, 0, 0, 0, -1e30f, 0.f, o1, l2);
    const float i2 = lam / l2;
    float ss = 0.f;
#pragma unroll
    for (int dt = 0; dt < 4; ++dt)
#pragma unroll
        for (int g = 0; g < 4; ++g) {
            const f32x4 v = park[(dt * 4 + g) * 512];
#pragma unroll
            for (int j = 0; j < 4; ++j) { const float a = v[j] - o1[dt][4 * g + j] * i2; o1[dt][4 * g + j] = a; ss += a * a; }
        }
    ss += xor32(ss);
    const float sc = rsqrtf(ss * (1.0f / 128.0f) + 1e-6f) * (1.0f - lam_init);
    bf16_t* dst = P.mo + (size_t)(row0 + wave * 32 + r31) * DM + hh * 128;
#pragma unroll
    for (int dt = 0; dt < 4; ++dt)
#pragma unroll
        for (int g = 0; g < 4; ++g) {
            const int d = 32 * dt + 8 * g + 4 * h;
            const f32x4 gg = *(const f32x4*)(P.a_subln_g + d);
            f32x4 v; v[0] = o1[dt][4 * g] * sc * gg[0]; v[1] = o1[dt][4 * g + 1] * sc * gg[1]; v[2] = o1[dt][4 * g + 2] * sc * gg[2]; v[3] = o1[dt][4 * g + 3] * sc * gg[3];
            st4bf(dst + d, v);
        }
}
__device__ __forceinline__ void sink_attn_item(CParams& P, LAS unsigned char* lds, int item) {
    const int tid = threadIdx.x, wave = tid >> 6, lane = tid & 63, h = lane >> 5, r31 = lane & 31;
    f32x16 o[4]; float l; int row0, hh;
    if (item < 256) {
        const int bs = item >> 7, qt = item & 7; hh = (item >> 3) & 15; const int kv = hh >> 2, q0 = qt * 256;
        const bf16_t* Q = P.qc_s + ((size_t)(bs * 16 + hh) * 2048 + q0 + wave * 32) * 128;
        const bf16_t* K = P.kc_s + (size_t)(bs * 4 + kv) * 2560 * 128; const bf16_t* Vt = P.vtc_s + (size_t)(bs * 4 + kv) * 128 * 2560;
        const int lo = q0 - 128 < 0 ? 0 : q0 - 128, hi = q0 + 384 > 2048 ? 2048 : q0 + 384;
        const float sk = P.c_sink[hh] * LOG2E;
        attn_pass<128>(lds, Q, 128, K, 128, Vt, 2560, 8 + (hi - lo) / 64, 8, 512 + lo, lo, q0 + wave * 32 + r31, q0 + wave * 32, sk, 0.5f, o, l);
        row0 = 4096 + bs * 2048 + q0;
    } else {
        const int bh = item - 256, b = bh >> 4; hh = bh & 15; const int kv = hh >> 2;
        const bf16_t* Q = P.qc_p + ((size_t)bh * 256 + wave * 32) * 128;
        const bf16_t* K = P.kc_p + (size_t)(b * 4 + kv) * 256 * 128; const bf16_t* Vt = P.vtc_p + (size_t)(b * 4 + kv) * 128 * 256;
        const float sk = P.c_sink[hh] * LOG2E;
        attn_pass<128>(lds, Q, 128, K, 128, Vt, 256, 4, 4, 0, 0, 0, 0, sk, 0.5f, o, l);
        row0 = b * 256;
    }
    const float il = 1.0f / l;
    bf16_t* dst = P.mo + (size_t)(row0 + wave * 32 + r31) * DM + hh * 128;
#pragma unroll
    for (int dt = 0; dt < 4; ++dt)
#pragma unroll
        for (int g = 0; g < 4; ++g) {
            f32x4 v; v[0] = o[dt][4 * g] * il; v[1] = o[dt][4 * g + 1] * il; v[2] = o[dt][4 * g + 2] * il; v[3] = o[dt][4 * g + 3] * il;
            st4bf(dst + 32 * dt + 8 * g + 4 * h, v);
        }
}

constexpr int G_QD = 0, G_KD = 8704, G_KDT = 17408, G_AD = 27648, G_BUF = 28160;
__device__ __forceinline__ void gla_item(CParams& P, LAS unsigned char* lds, int item) {
    const int tid = threadIdx.x, wave = tid >> 6, lane = tid & 63, h = lane >> 5, r31 = lane & 31;
    int row0, nch, hh, dir, sidx; bool lat;
    if (item < 16) { lat = true; sidx = item >> 3; hh = (item >> 1) & 3; dir = item & 1; row0 = 4096 + sidx * 2048; nch = 64; }
    else { lat = false; const int j = item - 16; sidx = j >> 3; hh = (j >> 1) & 3; dir = j & 1; row0 = sidx * 256; nch = 8; }
    const int eg = hh * 256 + wave * 32 + r31;
    f32x16 S[4];
    if (lat) {
        const float* st = (dir ? P.state_b : P.state_f) + (size_t)(sidx * 4 + hh) * 128 * 256 + wave * 32 + r31;
#pragma unroll
        for (int dt = 0; dt < 4; ++dt)
#pragma unroll
            for (int i = 0; i < 16; ++i) S[dt][i] = st[(size_t)(32 * dt + (i & 3) + 8 * (i >> 2) + 4 * h) * 256];
    } else {
#pragma unroll
        for (int dt = 0; dt < 4; ++dt)
#pragma unroll
            for (int i = 0; i < 16; ++i) S[dt][i] = 0.f;
    }
    const int pd = tid & 127, pg = tid >> 7;
    const bf16_t* QK = P.pb + hh * 128 + pd;
    const bf16_t* vbase = P.bvt + (size_t)eg * NTOK;
    const float* LC = P.lacum + (size_t)dir * 512 + hh * 128 + pd;
    for (int task = tid; task < nch * 128; task += 512) {
        const int tch = task >> 7, td = task & 127, tok0 = row0 + 32 * tch;
        const float* src = P.la + (size_t)dir * 512 + hh * 128 + td; float* dstc = P.lacum + (size_t)dir * 512 + hh * 128 + td;
        float v[32];
#pragma unroll
        for (int j2 = 0; j2 < 32; ++j2) v[j2] = src[(size_t)(tok0 + (dir ? 31 - j2 : j2)) * 1024];
        float run = 0.f;
#pragma unroll
        for (int j2 = 0; j2 < 32; ++j2) { run += v[j2]; dstc[(size_t)(tok0 + (dir ? 31 - j2 : j2)) * 1024] = run; }
    }
    float own[8]; bf16_t pq[8], pk[8];
    u32x2 vn_lo[2], vn_hi[2]; bf16x8 vn_b[2];
    auto prep_load = [&](int c) {
        const int ch = dir ? nch - 1 - c : c, tok0 = row0 + 32 * ch;
#pragma unroll
        for (int jj = 0; jj < 8; ++jj) {
            const int j2 = 8 * pg + jj, i = dir ? 31 - j2 : j2;
            own[jj] = LC[(size_t)(tok0 + i) * 1024];
            pq[jj] = QK[(size_t)(tok0 + i) * 3072]; pk[jj] = QK[(size_t)(tok0 + i) * 3072 + 512];
        }
        const bf16_t* vrow = vbase + tok0;
#pragma unroll
        for (int s2 = 0; s2 < 2; ++s2) { vn_lo[s2] = *(const u32x2*)(vrow + 16 * s2 + 4 * h); vn_hi[s2] = *(const u32x2*)(vrow + 16 * s2 + 8 + 4 * h); vn_b[s2] = *(const bf16x8*)(vrow + 16 * s2 + 8 * h); }
    };
    auto prep_finish = [&](int buf) {
        LAS unsigned char* B = lds + buf * G_BUF;
        float cum = 0.f;
        unsigned kp[8];
#pragma unroll
        for (int jj = 0; jj < 8; ++jj) {
            const int j2 = 8 * pg + jj, i = dir ? 31 - j2 : j2;
            cum = own[jj];
            const unsigned qd = f2bf(bf2f(pq[jj]) * __expf(cum)), kd = f2bf(bf2f(pk[jj]) * __expf(-cum));
            *(LAS bf16_t*)(B + G_QD + (i * 136 + pd) * 2) = (bf16_t)qd;
            *(LAS bf16_t*)(B + G_KD + (i * 136 + pd) * 2) = (bf16_t)kd;
            kp[jj] = kd;
        }
        const int i8 = dir ? 24 - 8 * pg : 8 * pg;
        u32x4 o;
        o[0] = dir ? (kp[7] | (kp[6] << 16)) : (kp[0] | (kp[1] << 16)); o[1] = dir ? (kp[5] | (kp[4] << 16)) : (kp[2] | (kp[3] << 16));
        o[2] = dir ? (kp[3] | (kp[2] << 16)) : (kp[4] | (kp[5] << 16)); o[3] = dir ? (kp[1] | (kp[0] << 16)) : (kp[6] | (kp[7] << 16));
        *(LAS u32x4*)(B + G_KDT + (pd * 40 + i8) * 2) = o;
        if (pg == 3) *(LAS float*)(B + G_AD + pd * 4) = __expf(cum);
    };
    __syncthreads();
    prep_load(0); prep_finish(0);
    u32x2 vc_lo[2], vc_hi[2]; bf16x8 vc_b[2];
#pragma unroll
    for (int s2 = 0; s2 < 2; ++s2) { vc_lo[s2] = vn_lo[s2]; vc_hi[s2] = vn_hi[s2]; vc_b[s2] = vn_b[s2]; }
    __syncthreads();
    float* OUT = dir ? P.ob : P.of;
    for (int c = 0; c < nch; ++c) {
        const int buf = c & 1;
        if (c + 1 < nch) prep_load(c + 1);
        const LAS unsigned char* B = lds + buf * G_BUF;
        const int ch = dir ? nch - 1 - c : c, tok0 = row0 + 32 * ch;
        f32x16 sT;
#pragma unroll
        for (int i = 0; i < 16; ++i) sT[i] = 0.f;
#pragma unroll
        for (int ks = 0; ks < 8; ++ks) {
            const bf16x8 a = *(const LAS bf16x8*)(B + G_KD + (r31 * 136 + 16 * ks + 8 * h) * 2);
            const bf16x8 b = *(const LAS bf16x8*)(B + G_QD + (r31 * 136 + 16 * ks + 8 * h) * 2);
            sT = mfma32(a, b, sT);
        }
#pragma unroll
        for (int i = 0; i < 16; ++i) { const int s = (i & 3) + 8 * (i >> 2) + 4 * h; const bool keep = dir ? (s >= r31) : (s <= r31); if (!keep) sT[i] = 0.f; }
        bf16x8 pb[2]; pb[0] = pack8(sT, 0); pb[1] = pack8(sT, 8);
        f32x16 oT;
#pragma unroll
        for (int i = 0; i < 16; ++i) oT[i] = 0.f;
#pragma unroll
        for (int dt = 0; dt < 4; ++dt)
#pragma unroll
            for (int s2 = 0; s2 < 2; ++s2) {
                const LAS unsigned char* qp = B + G_QD + (r31 * 136 + 32 * dt + 16 * s2 + 4 * h) * 2;
                const u32x2 lo = *(const LAS u32x2*)qp, hi = *(const LAS u32x2*)(qp + 16);
                u32x4 bv; bv[0] = lo[0]; bv[1] = lo[1]; bv[2] = hi[0]; bv[3] = hi[1];
                oT = mfma32(pack8(S[dt], 8 * s2), __builtin_bit_cast(bf16x8, bv), oT);
            }
#pragma unroll
        for (int s2 = 0; s2 < 2; ++s2) {
            u32x4 av; av[0] = vc_lo[s2][0]; av[1] = vc_lo[s2][1]; av[2] = vc_hi[s2][0]; av[3] = vc_hi[s2][1];
            oT = mfma32(__builtin_bit_cast(bf16x8, av), pb[s2], oT);
        }
        {
            float* op = OUT + (size_t)(tok0 + r31) * 1024 + hh * 256 + wave * 32 + 4 * h;
#pragma unroll
            for (int g = 0; g < 4; ++g) { f32x4 v; v[0] = oT[4 * g]; v[1] = oT[4 * g + 1]; v[2] = oT[4 * g + 2]; v[3] = oT[4 * g + 3]; *(f32x4*)(op + 8 * g) = v; }
        }
#pragma unroll
        for (int s2 = 0; s2 < 2; ++s2) {
#pragma unroll
            for (int dt = 0; dt < 4; ++dt) {
                const bf16x8 a = *(const LAS bf16x8*)(B + G_KDT + ((32 * dt + r31) * 40 + 16 * s2 + 8 * h) * 2);
                S[dt] = mfma32(a, vc_b[s2], S[dt]);
            }
        }
#pragma unroll
        for (int dt = 0; dt < 4; ++dt)
#pragma unroll
            for (int g = 0; g < 4; ++g) {
                const f32x4 ad = *(const LAS f32x4*)(B + G_AD + (32 * dt + 8 * g + 4 * h) * 4);
                S[dt][4 * g] *= ad[0]; S[dt][4 * g + 1] *= ad[1]; S[dt][4 * g + 2] *= ad[2]; S[dt][4 * g + 3] *= ad[3];
            }
        if (c + 1 < nch) {
            prep_finish(buf ^ 1);
#pragma unroll
            for (int s2 = 0; s2 < 2; ++s2) { vc_lo[s2] = vn_lo[s2]; vc_hi[s2] = vn_hi[s2]; vc_b[s2] = vn_b[s2]; }
        }
        __syncthreads();
    }
    if (!lat) {
        float* st = (dir ? P.new_b_b : P.new_b_f) + (size_t)(sidx * 4 + hh) * 128 * 256 + wave * 32 + r31;
#pragma unroll
        for (int dt = 0; dt < 4; ++dt)
#pragma unroll
            for (int i = 0; i < 16; ++i) st[(size_t)(32 * dt + (i & 3) + 8 * (i >> 2) + 4 * h) * 256] = S[dt][i];
    }
}

__device__ __forceinline__ void phase_mix0(CParams& P, LAS unsigned char* lds) {
    if (blockIdx.x < 144) gla_item(P, lds, blockIdx.x);
    if (blockIdx.x < 16) return;
    const float* lp = P.a_lambda;
    float s1 = 0.f, s2 = 0.f;
    for (int i = 0; i < 64; ++i) { s1 += lp[i] * lp[64 + i]; s2 += lp[128 + i] * lp[192 + i]; }
    const float lam_init = 0.2f, lam = __expf(s1) - __expf(s2) + lam_init;
    for (int it = blockIdx.x - 16; it < 256; it += gridDim.x - 16) diff_attn_item(P, lds, it, lam, lam_init);
}
__device__ __forceinline__ void phase_mix1(CParams& P, LAS unsigned char* lds) {
    for (int it = blockIdx.x; it < 512; it += gridDim.x) sink_attn_item(P, lds, it);
}


#define XB_TMO      128
#define XB_XCNT(j)  (256  + 64 * (j))
#define XB_XSUB(j)  (1280 + 64 * (j))
#define XB_XGEN(j)  (2304 + 64 * (j))
#define XB_TOP      3328
#define XB_TOPGEN   3392
#define XCD_BAR_WORDS 3456
#define XB_SPIN_CAP (1u << 18)
__device__ __forceinline__ unsigned xb_ld(unsigned* p)              { return __hip_atomic_load(p, __ATOMIC_RELAXED, __HIP_MEMORY_SCOPE_AGENT); }
__device__ __forceinline__ unsigned xb_add(unsigned* p, unsigned v) { return __hip_atomic_fetch_add(p, v, __ATOMIC_RELAXED, __HIP_MEMORY_SCOPE_AGENT); }
__device__ __forceinline__ unsigned xb_xcc_id() { return (unsigned)__builtin_amdgcn_s_getreg((3 << 11) | 20) & 0xFu; }
#define XB_SPIN(cond, bar) do { unsigned _sp = 0; while (cond) { __builtin_amdgcn_s_sleep(1); \
    if ((++_sp & 255u) == 0u) { if (xb_ld(&(bar)[XB_TMO])) break; if (_sp > XB_SPIN_CAP) { atomicAdd(&(bar)[XB_TMO], 1u); break; } } } } while (0)
struct XcdBarrier { unsigned* bar; unsigned x; volatile LAS unsigned* st; };
__device__ __forceinline__ XcdBarrier xcd_barrier_post(unsigned* bar, volatile LAS unsigned* st) {
    XcdBarrier b; b.bar = bar; b.x = xb_xcc_id(); b.st = st;
    if (threadIdx.x == 0) (void)xb_add(&bar[XB_XCNT(b.x)], 1u);
    return b;
}
__device__ __forceinline__ void xcd_barrier_complete(unsigned* bar, unsigned x, unsigned& nloc, unsigned& nx) {
    const unsigned G = gridDim.x * gridDim.y * gridDim.z;
    unsigned sum, cnt, mine, sp = 0u;
    for (;;) {
        sum = 0u; cnt = 0u; mine = 0u;
#pragma unroll
        for (unsigned j = 0; j < 16; ++j) { const unsigned c = xb_ld(&bar[XB_XCNT(j)]); sum += c; cnt += (c > 0u) ? 1u : 0u; mine = (j == x) ? c : mine; }
        if (sum == G) break;
        __builtin_amdgcn_s_sleep(1);
        if ((++sp & 255u) == 0u) { if (xb_ld(&bar[XB_TMO])) break; if (sp > XB_SPIN_CAP) { atomicAdd(&bar[XB_TMO], 1u); break; } }
    }
    nloc = mine > 0u ? mine : 1u; nx = cnt > 0u ? cnt : 1u;
}
__device__ __forceinline__ void xcd_barrier(const XcdBarrier& b) {
    asm volatile("s_waitcnt vmcnt(0)" ::: "memory");
    __syncthreads();
    if (threadIdx.x == 0) {
        unsigned* bar = b.bar;
        __builtin_amdgcn_s_waitcnt(0);
        unsigned nloc = b.st[0], nx = b.st[1];
        if (nloc == 0u) { xcd_barrier_complete(bar, b.x, nloc, nx); b.st[0] = nloc; b.st[1] = nx; }
        const unsigned old = xb_add(&bar[XB_XSUB(b.x)], 1u);
        const unsigned gen = old / nloc;
        if (old + 1u == (gen + 1u) * nloc) {
            __builtin_amdgcn_fence(__ATOMIC_RELEASE, "agent");
            asm volatile("s_waitcnt vmcnt(0)" ::: "memory");
            const unsigned og = xb_add(&bar[XB_TOP], 1u);
            const unsigned tg = og / nx;
            if (og + 1u == (tg + 1u) * nx) xb_add(&bar[XB_TOPGEN], 1u);
            else XB_SPIN(xb_ld(&bar[XB_TOPGEN]) == tg, bar);
            __builtin_amdgcn_fence(__ATOMIC_ACQUIRE, "agent");
            xb_add(&bar[XB_XGEN(b.x)], 1u);
            asm volatile("s_waitcnt vmcnt(0)" ::: "memory");
        } else {
            XB_SPIN(xb_ld(&bar[XB_XGEN(b.x)]) == gen, bar);
            __builtin_amdgcn_fence(__ATOMIC_ACQUIRE, "agent");
            asm volatile("s_waitcnt vmcnt(0)" ::: "memory");
        }
    }
    __syncthreads();
}

__global__ void __launch_bounds__(512, 2) fwd_megakernel(const Params Pk) {
    extern __shared__ __attribute__((aligned(16))) unsigned char shm[];
    LAS unsigned char* lds = (LAS unsigned char*)shm;
    cg::grid_group grid = cg::this_grid();
    CParams* kp = (CParams*)__builtin_amdgcn_kernarg_segment_ptr();
    const int phase_lo = Pk.phase_lo, phase_hi = Pk.phase_hi;
    int ph = 0;
    volatile LAS unsigned* xst = (volatile LAS unsigned*)(lds + pg8::STAGE_BYTES);
    if (threadIdx.x < 4) xst[threadIdx.x] = 0u;
    __syncthreads();
    const XcdBarrier xb = xcd_barrier_post(Pk.bar, xst);
#define PHASE(...) do { if (ph >= phase_lo && ph < phase_hi) { { CParams* pp = kp; asm volatile("" : "+s"(pp)); CParams& P = *pp; __VA_ARGS__; } if (ph + 1 < phase_hi) { if (ph == 0) grid.sync(); else xcd_barrier(xb); if (REP_SYNC >= 2) xcd_barrier(xb); } } ++ph; } while (0)
#define PHASE_R(REP, ...) do { PHASE(__VA_ARGS__); if ((REP) >= 2) PHASE(__VA_ARGS__); } while (0)
#define GEMM(EpiT, epi, Aptr, Btptr, Nn, Kk) do { pg8::Gemm g{Aptr, Btptr, NTOK, Nn, Kk}; pg8::StaticOrder S; S.init(NTOK, Nn, gridDim.x, blockIdx.x); EpiT E = epi; pg8::gemm_phase<EpiT>(lds, g, S, E); } while (0)
#define LAYER_HEAD(l) \
        PHASE_R(REP_NORM, phase_norm(P, l, 0, 0)); \
        PHASE_R(REP_FFNIN, GEMM(EpiSwiGLU, (EpiSwiGLU{P.act}), P.h, P.wt_in + (size_t)(l * 2) * 2 * DFF * DM, 2 * DFF, DM)); \
        PHASE(GEMM(EpiResid, (EpiResid{&P, l, 2, 0.5f}), P.act, P.wt_out + (size_t)(l * 2) * DM * DFF, DM, DFF)); \
        PHASE_R(REP_NORM, phase_norm(P, l, 1, 3));
#define LAYER_TAIL(l) \
        PHASE_R(REP_NORM, phase_norm(P, l, 2, 6)); \
        PHASE_R(REP_FFNIN, GEMM(EpiSwiGLU, (EpiSwiGLU{P.act}), P.h, P.wt_in + (size_t)(l * 2 + 1) * 2 * DFF * DM, 2 * DFF, DM)); \
        PHASE(GEMM(EpiResid, (EpiResid{&P, l, 8, 0.5f}), P.act, P.wt_out + (size_t)(l * 2 + 1) * DM * DFF, DM, DFF));
    PHASE_R(REP_PREP, phase_prep(P, lds));
    LAYER_HEAD(0)
    PHASE(GEMM(EpiAB, (EpiAB{&P}), P.h, P.wt_ab, 7168, DM));
    PHASE_R(REP_MIX0, phase_mix0(P, lds));
    PHASE_R(REP_NORM, phase_gla_merge(P));
    PHASE(GEMM(EpiResid, (EpiResid{&P, 0, 5, 1.0f}), P.mo, P.wt_abo, DM, DM));
    LAYER_TAIL(0)
    LAYER_HEAD(1)
    PHASE(GEMM(EpiC, (EpiC{&P}), P.h, P.wt_c, 3072, DM));
    PHASE_R(REP_MIX1, phase_mix1(P, lds));
    PHASE(GEMM(EpiResid, (EpiResid{&P, 1, 5, 1.0f}), P.mo, P.wt_co, DM, DM));
    LAYER_TAIL(1)
    PHASE_R(REP_NORM, phase_final_norm(P));
}
constexpr int N_PHASES = 1 + 11 + 10 + 1;

extern "C" void kernel_launch(void* const* d_in, const int* in_sizes, int n_in, void* d_out, int out_size, void* d_ws, size_t ws_size, hipStream_t stream) {
    Params p; memset(&p, 0, sizeof(p));
    const float* const* in = (const float* const*)d_in;
    p.x_prompt = in[0]; p.x_sample = in[1]; p.cache_a_k = in[2]; p.cache_a_v = in[3]; p.state_f = in[4]; p.state_b = in[5]; p.cache_c_k = in[6]; p.cache_c_v = in[7]; p.c = in[8]; p.c_ctx = in[9];
    p.ada_w = in[10]; p.ada_b = in[11]; p.norm_g = in[12]; p.ffn_w_in = in[13]; p.ffn_w_out = in[14]; p.ab_w_in = in[15]; p.ab_w_out = in[16]; p.a_lambda = in[17]; p.a_subln_g = in[18];
    p.alpha_w = in[19]; p.alpha_b = in[20]; p.b_norm_g = in[21]; p.c_w_in = in[22]; p.c_w_out = in[23]; p.c_sink = in[24]; p.final_g = in[25];
    float* out = (float*)d_out;
    p.y = out; p.new_a_k = out + 16777216; p.new_a_v = p.new_a_k + 4194304; p.new_b_f = p.new_a_v + 4194304; p.new_b_b = p.new_b_f + 2097152; p.new_c_k = p.new_b_b + 2097152; p.new_c_v = p.new_c_k + 2097152;
    char* w = (char*)d_ws; size_t off = 0;
    auto take = [&](size_t bytes) { char* r = w + off; off += (bytes + 255) & ~(size_t)255; return r; };
    p.mods = (float*)take((size_t)2 * 2 * 3 * NMODW * 4);
    p.xres = (float*)take((size_t)NTOK * DM * 4);
    p.h = (bf16_t*)take((size_t)NTOK * DM * 2);
    p.act = (bf16_t*)take((size_t)NTOK * DFF * 2);
    p.mo = (bf16_t*)take((size_t)NTOK * DM * 2);
    p.wt_in = (bf16_t*)take((size_t)4 * 2 * DFF * DM * 2);
    p.wt_out = (bf16_t*)take((size_t)4 * DM * DFF * 2);
    p.wt_ab = (bf16_t*)take((size_t)7168 * DM * 2);
    p.wt_abo = (bf16_t*)take((size_t)DM * DM * 2);
    p.wt_c = (bf16_t*)take((size_t)3072 * DM * 2);
    p.wt_co = (bf16_t*)take((size_t)DM * DM * 2);
    p.qa_p = (bf16_t*)take((size_t)16 * 8 * 256 * 128 * 2); p.ka_p = (bf16_t*)take((size_t)16 * 8 * 256 * 128 * 2); p.vta_p = (bf16_t*)take((size_t)16 * 8 * 256 * 128 * 2);
    p.qa_s = (bf16_t*)take((size_t)2 * 8 * 2048 * 128 * 2); p.ka_s = (bf16_t*)take((size_t)2 * 8 * 2560 * 128 * 2); p.vta_s = (bf16_t*)take((size_t)2 * 8 * 2560 * 128 * 2);
    p.qc_p = (bf16_t*)take((size_t)16 * 16 * 256 * 128 * 2); p.kc_p = (bf16_t*)take((size_t)16 * 4 * 256 * 128 * 2); p.vtc_p = (bf16_t*)take((size_t)16 * 4 * 256 * 128 * 2);
    p.qc_s = (bf16_t*)take((size_t)2 * 16 * 2048 * 128 * 2); p.kc_s = (bf16_t*)take((size_t)2 * 4 * 2560 * 128 * 2); p.vtc_s = (bf16_t*)take((size_t)2 * 4 * 2560 * 128 * 2);
    p.pb = (bf16_t*)take((size_t)NTOK * 3072 * 2);
    p.bvt = (bf16_t*)take((size_t)1024 * NTOK * 2);
    p.la = (float*)take((size_t)NTOK * 1024 * 4);
    p.lacum = (float*)take((size_t)NTOK * 1024 * 4);
    p.of = (float*)take((size_t)NTOK * 1024 * 4);
    p.ob = (float*)take((size_t)NTOK * 1024 * 4);
    p.park = (float*)take((size_t)512 * 16 * 512 * 16);
    p.bar = (unsigned*)take((size_t)XCD_BAR_WORDS * 4);
    int nj = 0, t0 = 0;
    auto job = [&](const float* src, bf16_t* dst, int lds_, int K, int N, int ldd, int map, int nb, long long sbs, long long dbs) {
        TJob& J = p.jobs[nj++]; J.src = src; J.dst = dst; J.lds = lds_; J.K = K; J.N = N; J.ldd = ldd; J.map = map; J.nbatch = nb; J.sbs = sbs; J.dbs = dbs; J.tile0 = t0; J.pad = 0;
        t0 += nb * (K / 128) * (N / 128);
    };
    for (int i = 0; i < 4; ++i) job(p.ffn_w_in + (size_t)i * DM * 2 * DFF, p.wt_in + (size_t)i * 2 * DFF * DM, 2 * DFF, DM, 2 * DFF, DM, 1, 1, 0, 0);
    for (int i = 0; i < 4; ++i) job(p.ffn_w_out + (size_t)i * DFF * DM, p.wt_out + (size_t)i * DM * DFF, DM, DFF, DM, DFF, 0, 1, 0, 0);
    job(p.ab_w_in, p.wt_ab, 6176, DM, 6144, DM, 0, 1, 0, 0);
    job(p.ab_w_out, p.wt_abo, DM, DM, DM, DM, 0, 1, 0, 0);
    job(p.c_w_in, p.wt_c, 3072, DM, 3072, DM, 2, 1, 0, 0);
    job(p.c_w_out, p.wt_co, DM, DM, DM, DM, 0, 1, 0, 0);
    job(p.cache_a_v, p.vta_s, 128, 512, 128, 2560, 0, 16, 512 * 128, 128 * 2560);
    job(p.cache_c_v, p.vtc_s, 128, 512, 128, 2560, 0, 8, 512 * 128, 128 * 2560);
    p.n_ttiles = t0;

    constexpr size_t kDynLds = pg8::STAGE_BYTES + 16;
    static int grid_blocks = 0;
    if (!grid_blocks) {
        int dev = 0, cus = 0, per_cu = 0;
        hipGetDevice(&dev);
        hipDeviceGetAttribute(&cus, hipDeviceAttributeMultiprocessorCount, dev);
        hipFuncSetAttribute((const void*)fwd_megakernel, hipFuncAttributeMaxDynamicSharedMemorySize, (int)kDynLds);
        hipOccupancyMaxActiveBlocksPerMultiprocessor(&per_cu, fwd_megakernel, 512, kDynLds);
        if (per_cu < 1) per_cu = 1;
        grid_blocks = cus * 1;
    }
#if N_LAUNCH_SPLIT
    for (int ph = 0; ph < N_PHASES; ++ph) {
        p.phase_lo = ph; p.phase_hi = ph + 1;
        hipLaunchKernelGGL(fwd_megakernel, dim3(grid_blocks), dim3(512), kDynLds, stream, p);
    }
#else
    p.phase_lo = 0; p.phase_hi = 1 << 20;
    (void)hipMemsetAsync(p.bar, 0, (size_t)XCD_BAR_WORDS * 4, stream);
    void* args[] = {&p};
    hipError_t e = hipLaunchCooperativeKernel((const void*)fwd_megakernel, dim3(grid_blocks), dim3(512), args, kDynLds, stream);
    if (e != hipSuccess) fprintf(stderr, "cooperative launch failed: %s (grid %d)\n", hipGetErrorString(e), grid_blocks);
#endif
}
```

```cpp
#include <hip/hip_runtime.h>
#include <hip/hip_cooperative_groups.h>
#include <stdint.h>
#include <string.h>
#include <stdio.h>
namespace cg = cooperative_groups;

typedef unsigned short bf16_t;
typedef short bf16x8 __attribute__((ext_vector_type(8)));
typedef float f32x4 __attribute__((ext_vector_type(4)));
typedef float f32x16 __attribute__((ext_vector_type(16)));
typedef unsigned u32x4 __attribute__((ext_vector_type(4)));
typedef unsigned u32x2 __attribute__((ext_vector_type(2)));
#define LAS __attribute__((address_space(3)))

#ifndef REP_PREP
#define REP_PREP 1
#endif
#ifndef REP_MIX0
#define REP_MIX0 1
#endif
#ifndef REP_MIX1
#define REP_MIX1 1
#endif
#ifndef REP_NORM
#define REP_NORM 1
#endif
#ifndef REP_FFNIN
#define REP_FFNIN 1
#endif
#ifndef REP_SYNC
#define REP_SYNC 1
#endif
#ifndef N_LAUNCH_SPLIT
#define N_LAUNCH_SPLIT 0
#endif

constexpr int NTOK = 8192, DM = 2048, DFF = 5632, NMODW = 18432;
constexpr float LOG2E = 1.4426950408889634f;
constexpr float LOG2_ROPE = 13.287712379549449f;

struct TJob { const float* src; bf16_t* dst; long long sbs, dbs; int lds, K, N, ldd, map, nbatch, tile0, pad; };

struct Params {
    const float *x_prompt, *x_sample, *cache_a_k, *cache_a_v, *state_f, *state_b, *cache_c_k, *cache_c_v, *c, *c_ctx;
    const float *ada_w, *ada_b, *norm_g, *ffn_w_in, *ffn_w_out, *ab_w_in, *ab_w_out, *a_lambda, *a_subln_g, *alpha_w, *alpha_b, *b_norm_g;
    const float *c_w_in, *c_w_out, *c_sink, *final_g;
    float *y, *new_a_k, *new_a_v, *new_b_f, *new_b_b, *new_c_k, *new_c_v;
    float* mods;
    float* xres;
    bf16_t* h;
    bf16_t* act;
    bf16_t* mo;
    bf16_t* wt_in;
    bf16_t* wt_out;
    bf16_t* wt_ab;
    bf16_t* wt_abo;
    bf16_t* wt_c;
    bf16_t* wt_co;
    bf16_t *qa_p, *ka_p, *vta_p;
    bf16_t *qa_s, *ka_s, *vta_s;
    bf16_t *qc_p, *kc_p, *vtc_p;
    bf16_t *qc_s, *kc_s, *vtc_s;
    bf16_t* pb;
    bf16_t* bvt;
    float* la;
    float* lacum;
    float *of, *ob;
    float* park;
    unsigned* bar;
    TJob jobs[14];
    int n_ttiles, phase_lo, phase_hi, n_early;
};

typedef const __attribute__((address_space(4))) Params CParams;

__device__ __forceinline__ unsigned f2bf(float f) { unsigned u = __float_as_uint(f); u += 0x7FFFu + ((u >> 16) & 1u); return u >> 16; }
__device__ __forceinline__ unsigned pk2(float lo, float hi) { return f2bf(lo) | (f2bf(hi) << 16); }
__device__ __forceinline__ float bf2f(bf16_t b) { return __uint_as_float(((unsigned)b) << 16); }
__device__ __forceinline__ float silu_f(float x) { return x / (1.0f + __expf(-x)); }
__device__ __forceinline__ int cond_of_row(int row) { return row < 4096 ? 0 : 1 + ((row - 4096) >> 11); }
__device__ __forceinline__ const float* modp(CParams& p, int kh, int l, int c) { return p.mods + (size_t)((kh * 2 + l) * 3 + c) * NMODW; }
__device__ __forceinline__ f32x4 mod4(CParams& p, int l, int c, int i, int col) {
    const f32x4 a = *(const f32x4*)(modp(p, 0, l, c) + i * DM + col), b = *(const f32x4*)(modp(p, 1, l, c) + i * DM + col);
    return a + b;
}
__device__ __forceinline__ f32x16 mfma32(bf16x8 a, bf16x8 b, f32x16 c) { return __builtin_amdgcn_mfma_f32_32x32x16_bf16(a, b, c, 0, 0, 0); }
__device__ __forceinline__ bf16x8 pack8(const f32x16& s, int base) {
    u32x4 r; r[0] = pk2(s[base + 0], s[base + 1]); r[1] = pk2(s[base + 2], s[base + 3]); r[2] = pk2(s[base + 4], s[base + 5]); r[3] = pk2(s[base + 6], s[base + 7]);
    return __builtin_bit_cast(bf16x8, r);
}
__device__ __forceinline__ float xor32(float v) { return __shfl_xor(v, 32, 64); }

namespace pg8 {
constexpr int BM = 256, BK = 64, HALF = 128, HTB = HALF * BK * 2, STAGE_BYTES = 8 * HTB, NXCD = 8, WGM = 8;
__device__ __forceinline__ int lds_byte(int r, int c) { const int st = (r >> 4) * 2 + (c >> 5), rr = r & 15, cc = c & 31, ob = rr * 64 + cc * 2; return st * 1024 + (ob ^ (((ob >> 9) & 1) << 5)); }
__device__ __forceinline__ void stage_rc(int b, int& R, int& C) { const int st = b / 1024, sb = b % 1024, swz = sb ^ (((sb >> 9) & 1) << 5); R = (st >> 1) * 16 + swz / 64; C = (st & 1) * 32 + (swz % 64) / 2; }
struct Unit { int pm, pn; };
struct Gemm { const bf16_t* A; const bf16_t* Bt; int M, N, K; };
struct StaticOrder {
    int nM, nN, nwg, G, c;
    __device__ void init(int M, int N, int G_, int c_) { nM = M / BM; nN = N / BM; nwg = nM * nN; G = G_; c = c_; }
    __device__ bool next(int i, Unit& u) const {
        const long L = (long)i * G + c; if (L >= nwg) return false;
        int wgid = (int)L; { const int q = nwg / NXCD, r = nwg % NXCD, xcd = wgid % NXCD, off = wgid / NXCD; wgid = (xcd < r ? xcd * (q + 1) : r * (q + 1) + (xcd - r) * q) + off; }
        const int nig = WGM * nN, gid = wgid / nig, fm = gid * WGM, gsz = (nM - fm) < WGM ? (nM - fm) : WGM;
        u.pm = fm + ((wgid % nig) % gsz); u.pn = (wgid % nig) / gsz; return true;
    }
};
template <class Epi>
__device__ __forceinline__ void gemm_phase(LAS unsigned char* lds, const Gemm g, const StaticOrder& S, const Epi& E) {
    const int tid = threadIdx.x, wid = __builtin_amdgcn_readfirstlane(tid >> 6), lane = tid & 63, wr = wid >> 2, wc = wid & 3, fr = lane & 15, fq = lane >> 4;
    const int K = g.K, nt = K / BK;
    unsigned voffA[2], voffB[2];
#pragma unroll
    for (int i = 0; i < 2; ++i) { int R, C; stage_rc(tid * 16 + i * 8192, R, C); voffA[i] = (unsigned)(R * K + C) * 2u; voffB[i] = voffA[i]; }
    const size_t kstep = (size_t)(BK * 2);
    const size_t hstep = (size_t)HALF * K * 2;
    const size_t tstep = 2 * hstep;
    const unsigned ldsw = (unsigned)wid * 1024u;
    const int aoff = lds_byte(wr * 64 + fr, fq * 8), boff = lds_byte(wc * 32 + fr, fq * 8);
#define PG8_SA(b, h) (((b) * 2 + (h)) * HTB)
#define PG8_SB(b, h) ((4 + (b) * 2 + (h)) * HTB)
#define PG8_STAGE(bufoff, gbase, voff) do { _Pragma("unroll") for (int _i = 0; _i < 2; ++_i) \
        __builtin_amdgcn_global_load_lds((const unsigned*)((const char*)(gbase) + (voff)[_i]), (LAS unsigned*)(lds + (bufoff) + ldsw + _i * 8192), 16, 0, 0); } while (0)
#define PG8_LDA(dst, b, h) do { _Pragma("unroll") for (int m = 0; m < 4; ++m) _Pragma("unroll") for (int k = 0; k < 2; ++k) dst[m][k] = *(const LAS bf16x8*)(lds + PG8_SA(b, h) + aoff + m * 2048 + k * 1024); } while (0)
#define PG8_LDB(dst, b, h) do { _Pragma("unroll") for (int n = 0; n < 2; ++n) _Pragma("unroll") for (int k = 0; k < 2; ++k) dst[n][k] = *(const LAS bf16x8*)(lds + PG8_SB(b, h) + boff + n * 2048 + k * 1024); } while (0)
#define PG8_MMA(ai, bj, At, Bt) do { __builtin_amdgcn_s_setprio(1); _Pragma("unroll") for (int m = 0; m < 4; ++m) _Pragma("unroll") for (int n = 0; n < 2; ++n) _Pragma("unroll") for (int k = 0; k < 2; ++k) \
        acc[ai][bj][m][n] = __builtin_amdgcn_mfma_f32_16x16x32_bf16(Bt[n][k], At[m][k], acc[ai][bj][m][n], 0, 0, 0); __builtin_amdgcn_s_setprio(0); } while (0)
#define PG8_WAIT_V(n) asm volatile("s_waitcnt vmcnt(" #n ")" ::: "memory")
#define PG8_WAIT_L(n) asm volatile("s_waitcnt lgkmcnt(" #n ")" ::: "memory")
#define PG8_BAR __builtin_amdgcn_s_barrier()
#define PG8_SCHED __builtin_amdgcn_sched_barrier(0)
    Unit cur, nxt; int ui = 0;
    if (!S.next(0, cur)) return;
    f32x4 acc[2][2][4][2];
#pragma unroll
    for (int a = 0; a < 2; ++a)
#pragma unroll
        for (int b = 0; b < 2; ++b)
#pragma unroll
            for (int m = 0; m < 4; ++m)
#pragma unroll
                for (int n = 0; n < 2; ++n) acc[a][b][m][n] = (f32x4){0.f, 0.f, 0.f, 0.f};
    bf16x8 At[4][2], B0[2][2], B1[2][2];
    const char* cA = (const char*)g.A + (size_t)cur.pm * tstep; const char* cB = (const char*)g.Bt + (size_t)cur.pn * tstep;
    PG8_STAGE(PG8_SB(0, 0), cB, voffB); PG8_STAGE(PG8_SA(0, 0), cA, voffA); PG8_STAGE(PG8_SB(0, 1), cB + hstep, voffB); PG8_STAGE(PG8_SA(0, 1), cA + hstep, voffA);
    if (wr == 1) PG8_BAR;
    PG8_WAIT_V(4); PG8_BAR;
    PG8_STAGE(PG8_SB(1, 0), cB + kstep, voffB); PG8_STAGE(PG8_SA(1, 0), cA + kstep, voffA); PG8_STAGE(PG8_SB(1, 1), cB + hstep + kstep, voffB);
    PG8_WAIT_V(6); PG8_BAR;
    for (;;) {
        const bool has_next = S.next(ui + 1, nxt);
        const char* nA = has_next ? (const char*)g.A + (size_t)nxt.pm * tstep : cA; const char* nB = has_next ? (const char*)g.Bt + (size_t)nxt.pn * tstep : cB;
        for (int t = 0; t < nt; t += 2) {
            const bool last = (t == nt - 2);
            const char* a1 = cA + (size_t)(t + 1) * kstep;
            const char* a2 = last ? nA : cA + (size_t)(t + 2) * kstep; const char* b2 = last ? nB : cB + (size_t)(t + 2) * kstep;
            const char* a3 = a2 + kstep; const char* b3 = b2 + kstep;
            PG8_LDB(B0, 0, 0); PG8_SCHED; PG8_LDA(At, 0, 0); PG8_STAGE(PG8_SA(1, 1), a1 + hstep, voffA);
            PG8_WAIT_L(8); PG8_BAR; PG8_WAIT_L(0); PG8_MMA(0, 0, At, B0); PG8_BAR; PG8_SCHED;
            PG8_LDB(B1, 0, 1); PG8_STAGE(PG8_SB(0, 0), b2, voffB);
            PG8_BAR; PG8_WAIT_L(0); PG8_MMA(0, 1, At, B1); PG8_BAR;
            PG8_LDA(At, 0, 1); PG8_STAGE(PG8_SA(0, 0), a2, voffA);
            PG8_BAR; PG8_WAIT_L(0); PG8_MMA(1, 0, At, B0); PG8_BAR; PG8_SCHED;
            PG8_STAGE(PG8_SB(0, 1), b2 + hstep, voffB);
            PG8_WAIT_V(6); PG8_BAR; PG8_MMA(1, 1, At, B1); PG8_BAR;
            PG8_LDB(B0, 1, 0); PG8_SCHED; PG8_LDA(At, 1, 0); PG8_STAGE(PG8_SA(0, 1), a2 + hstep, voffA);
            PG8_WAIT_L(8); PG8_BAR; PG8_WAIT_L(0); PG8_MMA(0, 0, At, B0); PG8_BAR; PG8_SCHED;
            PG8_LDB(B1, 1, 1); PG8_STAGE(PG8_SB(1, 0), b3, voffB);
            PG8_BAR; PG8_WAIT_L(0); PG8_MMA(0, 1, At, B1); PG8_BAR;
            PG8_LDA(At, 1, 1); PG8_STAGE(PG8_SA(1, 0), a3, voffA);
            PG8_BAR; PG8_WAIT_L(0); PG8_MMA(1, 0, At, B0); PG8_BAR; PG8_SCHED;
            PG8_STAGE(PG8_SB(1, 1), b3 + hstep, voffB);
            PG8_WAIT_V(6); PG8_BAR; PG8_MMA(1, 1, At, B1); PG8_BAR;
        }
        E(acc, cur, wr, wc, fr, fq);
        if (!has_next) break;
#pragma unroll
        for (int a = 0; a < 2; ++a)
#pragma unroll
            for (int b = 0; b < 2; ++b)
#pragma unroll
                for (int m = 0; m < 4; ++m)
#pragma unroll
                    for (int n = 0; n < 2; ++n) acc[a][b][m][n] = (f32x4){0.f, 0.f, 0.f, 0.f};
        cur = nxt; cA = nA; cB = nB; ++ui;
    }
    PG8_WAIT_V(0);
    if (wr == 0) PG8_BAR;
    PG8_BAR;
#undef PG8_SA
#undef PG8_SB
#undef PG8_STAGE
#undef PG8_LDA
#undef PG8_LDB
#undef PG8_MMA
#undef PG8_WAIT_V
#undef PG8_WAIT_L
#undef PG8_BAR
#undef PG8_SCHED
}
}
using pg8::Unit;
typedef f32x4 Acc[2][2][4][2];

struct EpiSwiGLU {
    bf16_t* act;
    __device__ __forceinline__ void operator()(const Acc& acc, const Unit& u, int wr, int wc, int fr, int fq) const {
#pragma unroll
        for (int ai = 0; ai < 2; ++ai)
#pragma unroll
            for (int m = 0; m < 4; ++m) {
                const int row = u.pm * 256 + ai * 128 + wr * 64 + m * 16 + fr;
                bf16_t* rp = act + (size_t)row * DFF + u.pn * 128 + wc * 32 + 4 * fq;
#pragma unroll
                for (int n = 0; n < 2; ++n) {
                    const f32x4 g = acc[ai][0][m][n], up = acc[ai][1][m][n];
                    u32x2 o; o[0] = pk2(silu_f(g[0]) * up[0], silu_f(g[1]) * up[1]); o[1] = pk2(silu_f(g[2]) * up[2], silu_f(g[3]) * up[3]);
                    *(u32x2*)(rp + 16 * n) = o;
                }
            }
    }
};
struct EpiResid {
    CParams* p; int l, gi; float gs;
    __device__ __forceinline__ void operator()(const Acc& acc, const Unit& u, int wr, int wc, int fr, int fq) const {
        const int cond = cond_of_row(u.pm * 256);
        f32x4 gt[2][2];
#pragma unroll
        for (int bj = 0; bj < 2; ++bj)
#pragma unroll
            for (int n = 0; n < 2; ++n) gt[bj][n] = mod4(*p, l, cond, gi, u.pn * 256 + bj * 128 + wc * 32 + 16 * n + 4 * fq) * gs;
#pragma unroll
        for (int ai = 0; ai < 2; ++ai)
#pragma unroll
            for (int m = 0; m < 4; ++m) {
                const int row = u.pm * 256 + ai * 128 + wr * 64 + m * 16 + fr;
                const int co = u.pn * 256 + wc * 32 + 4 * fq;
                float* rp = p->xres + (size_t)row * DM + co;
                const float* sp = (l == 0 && gi == 2) ? (row < 4096 ? p->x_prompt + (size_t)row * DM : p->x_sample + (size_t)(row - 4096) * DM) + co : rp;
#pragma unroll
                for (int bj = 0; bj < 2; ++bj)
#pragma unroll
                    for (int n = 0; n < 2; ++n) *(f32x4*)(rp + bj * 128 + 16 * n) = *(const f32x4*)(sp + bj * 128 + 16 * n) + gt[bj][n] * acc[ai][bj][m][n];
            }
    }
};
__device__ __forceinline__ void rope4(f32x4& x1, f32x4& x2, float pos, int i0, float expo_scale) {
#pragma unroll
    for (int j = 0; j < 4; ++j) {
        const float inv = __builtin_amdgcn_exp2f(-LOG2_ROPE * expo_scale * (float)(i0 + j));
        const float ang = pos * inv, cs = __cosf(ang), sn = __sinf(ang);
        const float a = x1[j], b = x2[j];
        x1[j] = a * cs - b * sn; x2[j] = a * sn + b * cs;
    }
}
__device__ __forceinline__ void st4bf(bf16_t* dst, const f32x4& v) { u32x2 o; o[0] = pk2(v[0], v[1]); o[1] = pk2(v[2], v[3]); *(u32x2*)dst = o; }
struct EpiAB {
    CParams* p;
    __device__ __forceinline__ void operator()(const Acc& acc, const Unit& u, int wr, int wc, int fr, int fq) const {
        CParams& P = *p;
#pragma unroll
        for (int bj = 0; bj < 2; ++bj) {
            const int cb = u.pn * 256 + bj * 128;
#pragma unroll
            for (int ai = 0; ai < 2; ++ai)
#pragma unroll
                for (int m = 0; m < 4; ++m) {
                    const int row = u.pm * 256 + ai * 128 + wr * 64 + m * 16 + fr;
                    f32x4 v0 = acc[ai][bj][m][0], v1 = acc[ai][bj][m][1];
                    const bool lat = row >= 4096;
                    const int b = row >> 8, pos = row & 255, ts = row - 4096, bs = ts >> 11, tt = ts & 2047;
                    if (cb < 3072) {
                        const int which = cb >> 10, hh = (cb & 1023) >> 7, d0 = wc * 32 + 4 * fq;
                        if (which < 2 && lat) rope4(v0, v1, (wc & 1) ? (float)(tt & 63) : (float)(tt >> 6), 4 * fq, 1.0f / 16.0f);
                        if (which == 0) {
                            v0 = v0 * (0.125f * LOG2E); v1 = v1 * (0.125f * LOG2E);
                            bf16_t* q = lat ? P.qa_s + ((size_t)(bs * 8 + hh) * 2048 + tt) * 128 : P.qa_p + ((size_t)(b * 8 + hh) * 256 + pos) * 128;
                            st4bf(q + d0, v0); st4bf(q + d0 + 16, v1);
                        } else if (which == 1) {
                            bf16_t* q = lat ? P.ka_s + ((size_t)(bs * 8 + hh) * 2560 + 512 + tt) * 128 : P.ka_p + ((size_t)(b * 8 + hh) * 256 + pos) * 128;
                            st4bf(q + d0, v0); st4bf(q + d0 + 16, v1);
                            if (!lat) { float* o = P.new_a_k + ((size_t)(b * 8 + hh) * 256 + pos) * 128 + d0; *(f32x4*)o = v0; *(f32x4*)(o + 16) = v1; }
                        } else {
                            bf16_t* q; int ld;
                            if (lat) { q = P.vta_s + (size_t)(bs * 8 + hh) * 128 * 2560 + 512 + tt; ld = 2560; } else { q = P.vta_p + (size_t)(b * 8 + hh) * 128 * 256 + pos; ld = 256; }
#pragma unroll
                            for (int j = 0; j < 4; ++j) { q[(size_t)(d0 + j) * ld] = (bf16_t)f2bf(v0[j]); q[(size_t)(d0 + 16 + j) * ld] = (bf16_t)f2bf(v1[j]); }
                            if (!lat) { float* o = P.new_a_v + ((size_t)(b * 8 + hh) * 256 + pos) * 128 + d0; *(f32x4*)o = v0; *(f32x4*)(o + 16) = v1; }
                        }
                    } else if (cb < 6144) {
                        const int c0 = cb - 3072 + wc * 32 + 4 * fq;
                        if (cb < 3584) { v0 = v0 * 0.08838834764831845f; v1 = v1 * 0.08838834764831845f; }
                        if (cb >= 4096 && cb < 5120) {
                            bf16_t* q = P.bvt + (size_t)(c0 - 1024) * NTOK + row;
#pragma unroll
                            for (int j = 0; j < 4; ++j) { q[(size_t)j * NTOK] = (bf16_t)f2bf(v0[j]); q[(size_t)(16 + j) * NTOK] = (bf16_t)f2bf(v1[j]); }
                        } else {
                            if (cb >= 5120) {
#pragma unroll
                                for (int j = 0; j < 4; ++j) { v0[j] = silu_f(v0[j]); v1[j] = silu_f(v1[j]); }
                            }
                            bf16_t* q = P.pb + (size_t)row * 3072 + c0;
                            st4bf(q, v0); st4bf(q + 16, v1);
                        }
                    } else {
                        const int c0 = cb - 6144 + wc * 32 + 4 * fq;
                        const f32x4 b0 = *(const f32x4*)(P.alpha_b + c0), b1 = *(const f32x4*)(P.alpha_b + c0 + 16);
#pragma unroll
                        for (int j = 0; j < 4; ++j) {
                            float x = v0[j] + b0[j]; v0[j] = (fminf(x, 0.f) - __logf(1.0f + __expf(-fabsf(x)))) * (1.0f / 16.0f);
                            x = v1[j] + b1[j];       v1[j] = (fminf(x, 0.f) - __logf(1.0f + __expf(-fabsf(x)))) * (1.0f / 16.0f);
                        }
                        float* q = P.la + (size_t)row * 1024 + c0;
                        *(f32x4*)q = v0; *(f32x4*)(q + 16) = v1;
                    }
                }
        }
    }
};
struct EpiC {
    CParams* p;
    __device__ __forceinline__ void operator()(const Acc& acc, const Unit& u, int wr, int wc, int fr, int fq) const {
        CParams& P = *p;
#pragma unroll
        for (int bj = 0; bj < 2; ++bj) {
            const int cb = u.pn * 256 + bj * 128;
#pragma unroll
            for (int ai = 0; ai < 2; ++ai)
#pragma unroll
                for (int m = 0; m < 4; ++m) {
                    const int row = u.pm * 256 + ai * 128 + wr * 64 + m * 16 + fr;
                    f32x4 v0 = acc[ai][bj][m][0], v1 = acc[ai][bj][m][1];
                    const bool lat = row >= 4096;
                    const int b = row >> 8, pos = row & 255, ts = row - 4096, bs = ts >> 11, tt = ts & 2047;
                    if (cb < 2560) {
                        const int gidx = wc >> 1, i0 = 16 * (wc & 1) + 4 * fq, d1 = 64 * gidx + i0;
                        if (lat) rope4(v0, v1, gidx ? (float)(tt & 63) : (float)(tt >> 6), i0, 1.0f / 32.0f);
                        if (cb < 2048) {
                            const int hh = cb >> 7;
                            v0 = v0 * (0.08838834764831845f * LOG2E); v1 = v1 * (0.08838834764831845f * LOG2E);
                            bf16_t* q = lat ? P.qc_s + ((size_t)(bs * 16 + hh) * 2048 + tt) * 128 : P.qc_p + ((size_t)(b * 16 + hh) * 256 + pos) * 128;
                            st4bf(q + d1, v0); st4bf(q + d1 + 32, v1);
                        } else {
                            const int kv = (cb - 2048) >> 7;
                            bf16_t* q = lat ? P.kc_s + ((size_t)(bs * 4 + kv) * 2560 + 512 + tt) * 128 : P.kc_p + ((size_t)(b * 4 + kv) * 256 + pos) * 128;
                            st4bf(q + d1, v0); st4bf(q + d1 + 32, v1);
                            if (!lat) { float* o = P.new_c_k + ((size_t)(b * 4 + kv) * 256 + pos) * 128 + d1; *(f32x4*)o = v0; *(f32x4*)(o + 32) = v1; }
                        }
                    } else {
                        const int kv = (cb - 2560) >> 7, d0 = wc * 32 + 4 * fq;
                        bf16_t* q; int ld;
                        if (lat) { q = P.vtc_s + (size_t)(bs * 4 + kv) * 128 * 2560 + 512 + tt; ld = 2560; } else { q = P.vtc_p + (size_t)(b * 4 + kv) * 128 * 256 + pos; ld = 256; }
#pragma unroll
                        for (int j = 0; j < 4; ++j) { q[(size_t)(d0 + j) * ld] = (bf16_t)f2bf(v0[j]); q[(size_t)(d0 + 16 + j) * ld] = (bf16_t)f2bf(v1[j]); }
                        if (!lat) { float* o = P.new_c_v + ((size_t)(b * 4 + kv) * 256 + pos) * 128 + d0; *(f32x4*)o = v0; *(f32x4*)(o + 16) = v1; }
                    }
                }
        }
    }
};

__device__ __forceinline__ int colmap(int map, int n) {
    if (map == 1) { const int t = n >> 8, w = n & 255; return (w < 128) ? t * 128 + w : DFF + t * 128 + (w - 128); }
    if (map == 2) { if (n >= 2560) return n; const int p = n & 63, i = (p >> 5) * 16 + (p & 15), s = (p >> 4) & 1; return (n & ~63) + i + 32 * s; }
    return n;
}
template <class JobT>
__device__ __forceinline__ void transpose_tile2(const JobT& J, int tl) {
    const int tid = threadIdx.x, wave = tid >> 6, lane = tid & 63;
    const int nkt = J.K >> 7, nnt = J.N >> 7;
    const int nsub = wave & 3, ksub = wave >> 2, kg = lane >> 3, c4 = lane & 7;
    const float* sp[2]; bf16_t* dp[2];
#pragma unroll
    for (int u = 0; u < 2; ++u) {
        const int t = tl + u, kt = t % nkt, r = t / nkt, nt = r % nnt, b = r / nnt;
        const int n = nt * 128 + nsub * 32 + c4 * 4, k = kt * 128 + ksub * 64 + kg * 8;
        sp[u] = J.src + (size_t)b * J.sbs + (size_t)k * J.lds + colmap(J.map, n);
        dp[u] = J.dst + (size_t)b * J.dbs + (size_t)n * J.ldd + k;
    }
    f32x4 v[2][8];
#pragma unroll
    for (int u = 0; u < 2; ++u)
#pragma unroll
        for (int i = 0; i < 8; ++i) v[u][i] = *(const f32x4*)(sp[u] + (size_t)i * J.lds);
#pragma unroll
    for (int u = 0; u < 2; ++u)
#pragma unroll
        for (int e = 0; e < 4; ++e) {
            u32x4 o; o[0] = pk2(v[u][0][e], v[u][1][e]); o[1] = pk2(v[u][2][e], v[u][3][e]); o[2] = pk2(v[u][4][e], v[u][5][e]); o[3] = pk2(v[u][6][e], v[u][7][e]);
            *(u32x4*)(dp[u] + (size_t)e * J.ldd) = o;
        }
}
constexpr int IT_ADA = 144, IT_XCP = 0, IT_CK = 384, IT_WEFF = 128, IT_E0 = IT_ADA + IT_XCP + IT_CK + IT_WEFF;
__device__ __forceinline__ void run_prep_items(CParams& P, LAS unsigned char* lds, int it_first, int it_end, int stride) {
    const int tid = threadIdx.x, wave = tid >> 6, lane = tid & 63;
    const int split = IT_E0 + P.n_early / 2;
    LAS float* sc = (LAS float*)lds;
    LAS float* red = (LAS float*)(lds + 12288);
    for (int it = it_first; it < it_end; it += stride) {
        if (it < IT_ADA || (it >= split && it < split + 144)) {
            const int l = it < IT_ADA ? 0 : 1, r = it < IT_ADA ? it : it - split, strip = r >> 1, kh = r & 1;
            for (int i = tid; i < 3072; i += 512) { const int c = i >> 10, k = kh * 1024 + (i & 1023); const float x = (c == 0) ? P.c_ctx[k] : P.c[(c - 1) * DM + k]; sc[i] = silu_f(x); }
            __syncthreads();
            const int kl0 = wave * 128;
            const float* W = P.ada_w + ((size_t)l * DM + kh * 1024 + kl0) * NMODW + strip * 256 + lane * 4;
            f32x4 a0 = {0, 0, 0, 0}, a1 = a0, a2 = a0;
#pragma unroll 8
            for (int k = 0; k < 128; ++k) {
                const f32x4 w = *(const f32x4*)(W + (size_t)k * NMODW);
                a0 += w * sc[kl0 + k]; a1 += w * sc[1024 + kl0 + k]; a2 += w * sc[2048 + kl0 + k];
            }
            *(LAS f32x4*)(red + (wave * 3 + 0) * 256 + lane * 4) = a0; *(LAS f32x4*)(red + (wave * 3 + 1) * 256 + lane * 4) = a1; *(LAS f32x4*)(red + (wave * 3 + 2) * 256 + lane * 4) = a2;
            __syncthreads();
            if (tid < 256) {
                const int col = strip * 256 + tid;
                const float bias = kh == 0 ? P.ada_b[(size_t)l * NMODW + col] : 0.f;
#pragma unroll
                for (int c = 0; c < 3; ++c) { float s = bias; for (int w = 0; w < 8; ++w) s += red[(w * 3 + c) * 256 + tid]; ((float*)modp(P, kh, l, c))[col] = s; }
            }
            __syncthreads();
        } else if (it < IT_ADA + IT_XCP) {
            const int j = it - IT_ADA;
#pragma unroll
            for (int i = 0; i < 8; ++i) {
                const size_t e = (size_t)j * 16384 + (size_t)(i * 512 + tid) * 4;
                const float* s = e < (size_t)4096 * DM ? P.x_prompt + e : P.x_sample + (e - (size_t)4096 * DM);
                *(f32x4*)(P.xres + e) = *(const f32x4*)s;
            }
        } else if (it < IT_ADA + IT_XCP + IT_CK) {
            const int j = it - IT_ADA - IT_XCP;
            const bool isa = j < 256; const int jj = isa ? j : j - 256;
            const float* s = isa ? P.cache_a_k : P.cache_c_k; bf16_t* d = isa ? P.ka_s : P.kc_s;
            const size_t e = (size_t)jj * 4096 + (size_t)tid * 8;
            const size_t bh = e >> 16, rem = e & 65535;
            const f32x4 v0 = *(const f32x4*)(s + e), v1 = *(const f32x4*)(s + e + 4);
            u32x4 o; o[0] = pk2(v0[0], v0[1]); o[1] = pk2(v0[2], v0[3]); o[2] = pk2(v1[0], v1[1]); o[3] = pk2(v1[2], v1[3]);
            *(u32x4*)(d + bh * (size_t)(2560 * 128) + rem) = o;
        } else if (it < IT_ADA + IT_XCP + IT_CK + IT_WEFF) {
            const int j = it - IT_ADA - IT_XCP - IT_CK;
            const int dir = (j * 8) >> 9;
            for (int kk = 0; kk < 4; ++kk) {
                const int k = tid + 512 * kk;
                float wl[16];
#pragma unroll
                for (int q = 0; q < 4; ++q) { const f32x4 t = *(const f32x4*)(P.ab_w_in + (size_t)k * 6176 + 6144 + 16 * dir + 4 * q); wl[4 * q] = t[0]; wl[4 * q + 1] = t[1]; wl[4 * q + 2] = t[2]; wl[4 * q + 3] = t[3]; }
#pragma unroll
                for (int jj = 0; jj < 8; ++jj) {
                    const int n = (j * 8 + jj) & 511; float s = 0.f;
#pragma unroll
                    for (int r = 0; r < 16; ++r) s += wl[r] * P.alpha_w[(size_t)(dir * 16 + r) * 512 + n];
                    P.wt_ab[(size_t)(6144 + j * 8 + jj) * DM + k] = (bf16_t)f2bf(s);
                }
            }
        } else {
            const int tl = it < split ? 2 * (it - IT_E0) : P.n_early + 2 * (it - split - 144);
            int ji = 0;
            for (int q = 1; q < 14; ++q) if (tl >= P.jobs[q].tile0) ji = q;
            transpose_tile2(P.jobs[ji], tl - P.jobs[ji].tile0);
        }
    }
}

__device__ __forceinline__ void phase_norm(CParams& P, int l, int which, int si) {
    const int tid = threadIdx.x, wave = tid >> 6, lane = tid & 63;
    const float* g = P.norm_g + (size_t)(l * 3 + which) * DM;
    for (int row = blockIdx.x * 8 + wave; row < NTOK; row += gridDim.x * 8) {
        const float* xp = (l == 0 && which == 0) ? (row < 4096 ? P.x_prompt + (size_t)row * DM : P.x_sample + (size_t)(row - 4096) * DM) : P.xres + (size_t)row * DM;
        const int cond = cond_of_row(row);
        f32x4 v[8]; float ss = 0.f;
#pragma unroll
        for (int i = 0; i < 8; ++i) { v[i] = *(const f32x4*)(xp + 4 * lane + 256 * i); ss += v[i][0] * v[i][0] + v[i][1] * v[i][1] + v[i][2] * v[i][2] + v[i][3] * v[i][3]; }
#pragma unroll
        for (int o = 32; o >= 1; o >>= 1) ss += __shfl_xor(ss, o, 64);
        const float rstd = rsqrtf(ss * (1.0f / DM) + 1e-6f);
#pragma unroll
        for (int i = 0; i < 8; ++i) {
            const int col = 4 * lane + 256 * i;
            const f32x4 gg = *(const f32x4*)(g + col), sh = mod4(P, l, cond, si, col), scl = mod4(P, l, cond, si + 1, col);
            const f32x4 y = (v[i] * rstd) * gg * (scl + 1.0f) + sh;
            st4bf(P.h + (size_t)row * DM + col, y);
        }
    }
}
__device__ __forceinline__ void phase_final_norm(CParams& P) {
    const int tid = threadIdx.x, wave = tid >> 6, lane = tid & 63;
    for (int row = blockIdx.x * 8 + wave; row < NTOK; row += gridDim.x * 8) {
        const float* xp = P.xres + (size_t)row * DM;
        f32x4 v[8]; float ss = 0.f;
#pragma unroll
        for (int i = 0; i < 8; ++i) { v[i] = *(const f32x4*)(xp + 4 * lane + 256 * i); ss += v[i][0] * v[i][0] + v[i][1] * v[i][1] + v[i][2] * v[i][2] + v[i][3] * v[i][3]; }
#pragma unroll
        for (int o = 32; o >= 1; o >>= 1) ss += __shfl_xor(ss, o, 64);
        const float rstd = rsqrtf(ss * (1.0f / DM) + 1e-6f);
#pragma unroll
        for (int i = 0; i < 8; ++i) { const int col = 4 * lane + 256 * i; *(f32x4*)(P.y + (size_t)row * DM + col) = (v[i] * rstd) * *(const f32x4*)(P.final_g + col); }
    }
}
__device__ __forceinline__ void phase_gla_merge(CParams& P) {
    const int tid = threadIdx.x, wave = tid >> 6, lane = tid & 63;
    for (int it = blockIdx.x * 8 + wave; it < NTOK * 4; it += gridDim.x * 8) {
        const int row = it >> 2, hh = it & 3, col = hh * 256 + 4 * lane;
        const f32x4 a = *(const f32x4*)(P.of + (size_t)row * 1024 + col) + *(const f32x4*)(P.ob + (size_t)row * 1024 + col);
        float ss = a[0] * a[0] + a[1] * a[1] + a[2] * a[2] + a[3] * a[3];
#pragma unroll
        for (int o = 32; o >= 1; o >>= 1) ss += __shfl_xor(ss, o, 64);
        const float rstd = rsqrtf(ss * (1.0f / 256.0f) + 1e-6f);
        const f32x4 g = *(const f32x4*)(P.b_norm_g + 4 * lane);
        const u32x2 br = *(const u32x2*)(P.pb + (size_t)row * 3072 + 2048 + col);
        f32x4 r; r[0] = __uint_as_float(br[0] << 16); r[1] = __uint_as_float(br[0] & 0xffff0000u); r[2] = __uint_as_float(br[1] << 16); r[3] = __uint_as_float(br[1] & 0xffff0000u);
        st4bf(P.mo + (size_t)row * DM + 1024 + col, a * rstd * g * r);
    }
}

constexpr int KS_BYTES = 64 * 136 * 2, VS_BYTES = 128 * 72 * 2, VS_OFF = 2 * KS_BYTES;
template <int DQ>
__device__ __forceinline__ void attn_pass(LAS unsigned char* lds, const bf16_t* Qw, int ldq, const bf16_t* Kb, int ldk, const bf16_t* Vt, int ldv,
                                          int nt, int t_band0, int kidx_band0, int kp_band0, int qpos, int qw0,
                                          float m0, float l0, f32x16 (&o)[4], float& l_out) {
    const int tid = threadIdx.x, lane = tid & 63, h = lane >> 5, r31 = lane & 31;
    constexpr int KROW = DQ + 8, KCH = DQ / 8, NKC = (64 * KCH) / 512;
    bf16x8 qf[DQ / 16];
#pragma unroll
    for (int ks = 0; ks < DQ / 16; ++ks) qf[ks] = *(const bf16x8*)(Qw + (size_t)r31 * ldq + 16 * ks + 8 * h);
#pragma unroll
    for (int dt = 0; dt < 4; ++dt)
#pragma unroll
        for (int i = 0; i < 16; ++i) o[dt][i] = 0.f;
    float m = m0, l = l0;
    u32x4 kreg[NKC], vreg[2];
    auto kidx_of = [&](int t) { return t < t_band0 ? 64 * t : kidx_band0 + 64 * (t - t_band0); };
    auto load_regs = [&](int t) {
        const int k0 = kidx_of(t);
#pragma unroll
        for (int i = 0; i < NKC; ++i) { const int c = tid + 512 * i, key = c / KCH, ch = c % KCH; kreg[i] = *(const u32x4*)(Kb + (size_t)(k0 + key) * ldk + 8 * ch); }
#pragma unroll
        for (int i = 0; i < 2; ++i) { const int c = tid + 512 * i, d = c >> 3, ch = c & 7; vreg[i] = *(const u32x4*)(Vt + (size_t)d * ldv + k0 + 8 * ch); }
    };
    auto store_lds = [&](int buf) {
#pragma unroll
        for (int i = 0; i < NKC; ++i) { const int c = tid + 512 * i, key = c / KCH, ch = c % KCH; *(LAS u32x4*)(lds + buf * KS_BYTES + (key * KROW + 8 * ch) * 2) = kreg[i]; }
#pragma unroll
        for (int i = 0; i < 2; ++i) { const int c = tid + 512 * i, d = c >> 3, ch = c & 7; *(LAS u32x4*)(lds + VS_OFF + buf * VS_BYTES + (d * 72 + 8 * ch) * 2) = vreg[i]; }
    };
    __syncthreads();
    load_regs(0); store_lds(0);
    __syncthreads();
    for (int t = 0; t < nt; ++t) {
        const int buf = t & 1;
        if (t + 1 < nt) load_regs(t + 1);
        const bool band = t >= t_band0;
        const int kp0 = kp_band0 + 64 * (t - t_band0);
        const bool skip = band && (kp0 > qw0 + 31 + 128 || kp0 + 63 < qw0 - 128);
        if (!skip) {
            f32x16 s[2];
#pragma unroll
            for (int kt = 0; kt < 2; ++kt) {
#pragma unroll
                for (int i = 0; i < 16; ++i) s[kt][i] = 0.f;
#pragma unroll
                for (int ks = 0; ks < DQ / 16; ++ks) {
                    const bf16x8 a = *(const LAS bf16x8*)(lds + buf * KS_BYTES + ((kt * 32 + r31) * KROW + 16 * ks + 8 * h) * 2);
                    s[kt] = mfma32(a, qf[ks], s[kt]);
                }
            }
            if (band) {
#pragma unroll
                for (int kt = 0; kt < 2; ++kt)
#pragma unroll
                    for (int i = 0; i < 16; ++i) { const int kp = kp0 + 32 * kt + (i & 3) + 8 * (i >> 2) + 4 * h; const int dlt = qpos - kp; if (dlt > 128 || dlt < -128) s[kt][i] = -1e30f; }
            }
            float mx = s[0][0];
#pragma unroll
            for (int kt = 0; kt < 2; ++kt)
#pragma unroll
                for (int i = 0; i < 16; ++i) mx = fmaxf(mx, s[kt][i]);
            mx = fmaxf(mx, xor32(mx));
            const float mn = fmaxf(m, mx), alpha = __builtin_amdgcn_exp2f(m - mn);
            m = mn;
            float ps = 0.f;
#pragma unroll
            for (int kt = 0; kt < 2; ++kt)
#pragma unroll
                for (int i = 0; i < 16; ++i) { const float pv = __builtin_amdgcn_exp2f(s[kt][i] - mn); s[kt][i] = pv; ps += pv; }
            l = l * alpha + ps;
#pragma unroll
            for (int dt = 0; dt < 4; ++dt)
#pragma unroll
                for (int i = 0; i < 16; ++i) o[dt][i] *= alpha;
            bf16x8 pb[2][2];
#pragma unroll
            for (int kt = 0; kt < 2; ++kt) { pb[kt][0] = pack8(s[kt], 0); pb[kt][1] = pack8(s[kt], 8); }
#pragma unroll
            for (int dt = 0; dt < 4; ++dt)
#pragma unroll
                for (int kt = 0; kt < 2; ++kt)
#pragma unroll
                    for (int s2 = 0; s2 < 2; ++s2) {
                        const LAS unsigned char* vp = lds + VS_OFF + buf * VS_BYTES + ((dt * 32 + r31) * 72 + 32 * kt + 16 * s2 + 4 * h) * 2;
                        const u32x2 lo = *(const LAS u32x2*)vp, hi = *(const LAS u32x2*)(vp + 16);
                        u32x4 av; av[0] = lo[0]; av[1] = lo[1]; av[2] = hi[0]; av[3] = hi[1];
                        o[dt] = mfma32(__builtin_bit_cast(bf16x8, av), pb[kt][s2], o[dt]);
                    }
        }
        if (t + 1 < nt) store_lds(buf ^ 1);
        __syncthreads();
    }
    l_out = l + xor32(l);
}

__device__ __forceinline__ void diff_attn_item(CParams& P, LAS unsigned char* lds, int item, float lam, float lam_init) {
    const int tid = threadIdx.x, wave = tid >> 6, lane = tid & 63, h = lane >> 5, r31 = lane & 31;
    const bf16_t *Q, *K, *Vt; int nk, row0;
    if (item < 128) { const int bh = item >> 3, qt = item & 7; Q = P.qa_s + ((size_t)bh * 2048 + qt * 256) * 128; K = P.ka_s + (size_t)bh * 2560 * 128; Vt = P.vta_s + (size_t)bh * 128 * 2560; nk = 2560; row0 = 4096 + (bh >> 3) * 2048 + qt * 256; }
    else { const int bh = item - 128; Q = P.qa_p + (size_t)bh * 256 * 128; K = P.ka_p + (size_t)bh * 256 * 128; Vt = P.vta_p + (size_t)bh * 128 * 256; nk = 256; row0 = (bh >> 3) * 256; }
    const int hh = (item < 128 ? (item >> 3) : (item - 128)) & 7;
    f32x16 o1[4]; float l1, l2;
    f32x4* park = (f32x4*)P.park + (size_t)blockIdx.x * 16 * 512 + tid;
    attn_pass<64>(lds, Q + (size_t)(wave * 32) * 128, 128, K, 128, Vt, nk, nk / 64, nk / 64, 0, 0, 0, 0, -1e30f, 0.f, o1, l1);
    {
        const float i1 = 1.0f / l1;
#pragma unroll
        for (int dt = 0; dt < 4; ++dt)
#pragma unroll
            for (int g = 0; g < 4; ++g) { f32x4 v; v[0] = o1[dt][4 * g] * i1; v[1] = o1[dt][4 * g + 1] * i1; v[2] = o1[dt][4 * g + 2] * i1; v[3] = o1[dt][4 * g + 3] * i1; park[(dt * 4 + g) * 512] = v; }
    }
    attn_pass<64>(lds, Q + (size_t)(wave * 32) * 128 + 64, 128, K + 64, 128, Vt, nk, nk / 64, nk / 64, 0, 0, 0, 0, -1e30f, 0.f, o1, l2);
    const float i2 = lam / l2;
    float ss = 0.f;
#pragma unroll
    for (int dt = 0; dt < 4; ++dt)
#pragma unroll
        for (int g = 0; g < 4; ++g) {
            const f32x4 v = park[(dt * 4 + g) * 512];
#pragma unroll
            for (int j = 0; j < 4; ++j) { const float a = v[j] - o1[dt][4 * g + j] * i2; o1[dt][4 * g + j] = a; ss += a * a; }
        }
    ss += xor32(ss);
    const float sc = rsqrtf(ss * (1.0f / 128.0f) + 1e-6f) * (1.0f - lam_init);
    bf16_t* dst = P.mo + (size_t)(row0 + wave * 32 + r31) * DM + hh * 128;
#pragma unroll
    for (int dt = 0; dt < 4; ++dt)
#pragma unroll
        for (int g = 0; g < 4; ++g) {
            const int d = 32 * dt + 8 * g + 4 * h;
            const f32x4 gg = *(const f32x4*)(P.a_subln_g + d);
            f32x4 v; v[0] = o1[dt][4 * g] * sc * gg[0]; v[1] = o1[dt][4 * g + 1] * sc * gg[1]; v[2] = o1[dt][4 * g + 2] * sc * gg[2]; v[3] = o1[dt][4 * g + 3] * sc * gg[3];
            st4bf(dst + d, v);
        }
}
__device__ __forceinline__ void sink_attn_item(CParams& P, LAS unsigned char* lds, int item) {
    const int tid = threadIdx.x, wave = tid >> 6, lane = tid & 63, h = lane >> 5, r31 = lane & 31;
    f32x16 o[4]; float l; int row0, hh;
    if (item < 256) {
        const int bs = item >> 7, qt = item & 7; hh = (item >> 3) & 15; const int kv = hh >> 2, q0 = qt * 256;
        const bf16_t* Q = P.qc_s + ((size_t)(bs * 16 + hh) * 2048 + q0 + wave * 32) * 128;
        const bf16_t* K = P.kc_s + (size_t)(bs * 4 + kv) * 2560 * 128; const bf16_t* Vt = P.vtc_s + (size_t)(bs * 4 + kv) * 128 * 2560;
        const int lo = q0 - 128 < 0 ? 0 : q0 - 128, hi = q0 + 384 > 2048 ? 2048 : q0 + 384;
        const float sk = P.c_sink[hh] * LOG2E;
        attn_pass<128>(lds, Q, 128, K, 128, Vt, 2560, 8 + (hi - lo) / 64, 8, 512 + lo, lo, q0 + wave * 32 + r31, q0 + wave * 32, sk, 0.5f, o, l);
        row0 = 4096 + bs * 2048 + q0;
    } else {
        const int bh = item - 256, b = bh >> 4; hh = bh & 15; const int kv = hh >> 2;
        const bf16_t* Q = P.qc_p + ((size_t)bh * 256 + wave * 32) * 128;
        const bf16_t* K = P.kc_p + (size_t)(b * 4 + kv) * 256 * 128; const bf16_t* Vt = P.vtc_p + (size_t)(b * 4 + kv) * 128 * 256;
        const float sk = P.c_sink[hh] * LOG2E;
        attn_pass<128>(lds, Q, 128, K, 128, Vt, 256, 4, 4, 0, 0, 0, 0, sk, 0.5f, o, l);
        row0 = b * 256;
    }
    const float il = 1.0f / l;
    bf16_t* dst = P.mo + (size_t)(row0 + wave * 32 + r31) * DM + hh * 128;
#pragma unroll
    for (int dt = 0; dt < 4; ++dt)
#pragma unroll
        for (int g = 0; g < 4; ++g) {
            f32x4 v; v[0] = o[dt][4 * g] * il; v[1] = o[dt][4 * g + 1] * il; v[2] = o[dt][4 * g + 2] * il; v[3] = o[dt][4 * g + 3] * il;
            st4bf(dst + 32 * dt + 8 * g + 4 * h, v);
        }
}

constexpr int G_QD = 0, G_KD = 8704, G_KDT = 17408, G_AD = 27648, G_BUF = 28160;
__device__ __forceinline__ void gla_item(CParams& P, LAS unsigned char* lds, int item) {
    const int tid = threadIdx.x, wave = tid >> 6, lane = tid & 63, h = lane >> 5, r31 = lane & 31;
    int row0, nch, hh, dir, sidx; bool lat;
    if (item < 16) { lat = true; sidx = item >> 3; hh = (item >> 1) & 3; dir = item & 1; row0 = 4096 + sidx * 2048; nch = 64; }
    else { lat = false; const int j = item - 16; sidx = j >> 3; hh = (j >> 1) & 3; dir = j & 1; row0 = sidx * 256; nch = 8; }
    const int eg = hh * 256 + wave * 32 + r31;
    f32x16 S[4];
    if (lat) {
        const float* st = (dir ? P.state_b : P.state_f) + (size_t)(sidx * 4 + hh) * 128 * 256 + wave * 32 + r31;
#pragma unroll
        for (int dt = 0; dt < 4; ++dt)
#pragma unroll
            for (int i = 0; i < 16; ++i) S[dt][i] = st[(size_t)(32 * dt + (i & 3) + 8 * (i >> 2) + 4 * h) * 256];
    } else {
#pragma unroll
        for (int dt = 0; dt < 4; ++dt)
#pragma unroll
            for (int i = 0; i < 16; ++i) S[dt][i] = 0.f;
    }
    const int pd = tid & 127, pg = tid >> 7;
    const bf16_t* QK = P.pb + hh * 128 + pd;
    const bf16_t* vbase = P.bvt + (size_t)eg * NTOK;
    const float* LC = P.lacum + (size_t)dir * 512 + hh * 128 + pd;
    for (int task = tid; task < nch * 128; task += 512) {
        const int tch = task >> 7, td = task & 127, tok0 = row0 + 32 * tch;
        const float* src = P.la + (size_t)dir * 512 + hh * 128 + td; float* dstc = P.lacum + (size_t)dir * 512 + hh * 128 + td;
        float v[32];
#pragma unroll
        for (int j2 = 0; j2 < 32; ++j2) v[j2] = src[(size_t)(tok0 + (dir ? 31 - j2 : j2)) * 1024];
        float run = 0.f;
#pragma unroll
        for (int j2 = 0; j2 < 32; ++j2) { run += v[j2]; dstc[(size_t)(tok0 + (dir ? 31 - j2 : j2)) * 1024] = run; }
    }
    float own[8]; bf16_t pq[8], pk[8];
    u32x2 vn_lo[2], vn_hi[2]; bf16x8 vn_b[2];
    auto prep_load = [&](int c) {
        const int ch = dir ? nch - 1 - c : c, tok0 = row0 + 32 * ch;
#pragma unroll
        for (int jj = 0; jj < 8; ++jj) {
            const int j2 = 8 * pg + jj, i = dir ? 31 - j2 : j2;
            own[jj] = LC[(size_t)(tok0 + i) * 1024];
            pq[jj] = QK[(size_t)(tok0 + i) * 3072]; pk[jj] = QK[(size_t)(tok0 + i) * 3072 + 512];
        }
        const bf16_t* vrow = vbase + tok0;
#pragma unroll
        for (int s2 = 0; s2 < 2; ++s2) { vn_lo[s2] = *(const u32x2*)(vrow + 16 * s2 + 4 * h); vn_hi[s2] = *(const u32x2*)(vrow + 16 * s2 + 8 + 4 * h); vn_b[s2] = *(const bf16x8*)(vrow + 16 * s2 + 8 * h); }
    };
    auto prep_finish = [&](int buf) {
        LAS unsigned char* B = lds + buf * G_BUF;
        float cum = 0.f;
        unsigned kp[8];
#pragma unroll
        for (int jj = 0; jj < 8; ++jj) {
            const int j2 = 8 * pg + jj, i = dir ? 31 - j2 : j2;
            cum = own[jj];
            const unsigned qd = f2bf(bf2f(pq[jj]) * __expf(cum)), kd = f2bf(bf2f(pk[jj]) * __expf(-cum));
            *(LAS bf16_t*)(B + G_QD + (i * 136 + pd) * 2) = (bf16_t)qd;
            *(LAS bf16_t*)(B + G_KD + (i * 136 + pd) * 2) = (bf16_t)kd;
            kp[jj] = kd;
        }
        const int i8 = dir ? 24 - 8 * pg : 8 * pg;
        u32x4 o;
        o[0] = dir ? (kp[7] | (kp[6] << 16)) : (kp[0] | (kp[1] << 16)); o[1] = dir ? (kp[5] | (kp[4] << 16)) : (kp[2] | (kp[3] << 16));
        o[2] = dir ? (kp[3] | (kp[2] << 16)) : (kp[4] | (kp[5] << 16)); o[3] = dir ? (kp[1] | (kp[0] << 16)) : (kp[6] | (kp[7] << 16));
        *(LAS u32x4*)(B + G_KDT + (pd * 40 + i8) * 2) = o;
        if (pg == 3) *(LAS float*)(B + G_AD + pd * 4) = __expf(cum);
    };
    __syncthreads();
    prep_load(0); prep_finish(0);
    u32x2 vc_lo[2], vc_hi[2]; bf16x8 vc_b[2];
#pragma unroll
    for (int s2 = 0; s2 < 2; ++s2) { vc_lo[s2] = vn_lo[s2]; vc_hi[s2] = vn_hi[s2]; vc_b[s2] = vn_b[s2]; }
    __syncthreads();
    float* OUT = dir ? P.ob : P.of;
    for (int c = 0; c < nch; ++c) {
        const int buf = c & 1;
        if (c + 1 < nch) prep_load(c + 1);
        const LAS unsigned char* B = lds + buf * G_BUF;
        const int ch = dir ? nch - 1 - c : c, tok0 = row0 + 32 * ch;
        f32x16 sT;
#pragma unroll
        for (int i = 0; i < 16; ++i) sT[i] = 0.f;
#pragma unroll
        for (int ks = 0; ks < 8; ++ks) {
            const bf16x8 a = *(const LAS bf16x8*)(B + G_KD + (r31 * 136 + 16 * ks + 8 * h) * 2);
            const bf16x8 b = *(const LAS bf16x8*)(B + G_QD + (r31 * 136 + 16 * ks + 8 * h) * 2);
            sT = mfma32(a, b, sT);
        }
#pragma unroll
        for (int i = 0; i < 16; ++i) { const int s = (i & 3) + 8 * (i >> 2) + 4 * h; const bool keep = dir ? (s >= r31) : (s <= r31); if (!keep) sT[i] = 0.f; }
        bf16x8 pb[2]; pb[0] = pack8(sT, 0); pb[1] = pack8(sT, 8);
        f32x16 oT;
#pragma unroll
        for (int i = 0; i < 16; ++i) oT[i] = 0.f;
#pragma unroll
        for (int dt = 0; dt < 4; ++dt)
#pragma unroll
            for (int s2 = 0; s2 < 2; ++s2) {
                const LAS unsigned char* qp = B + G_QD + (r31 * 136 + 32 * dt + 16 * s2 + 4 * h) * 2;
                const u32x2 lo = *(const LAS u32x2*)qp, hi = *(const LAS u32x2*)(qp + 16);
                u32x4 bv; bv[0] = lo[0]; bv[1] = lo[1]; bv[2] = hi[0]; bv[3] = hi[1];
                oT = mfma32(pack8(S[dt], 8 * s2), __builtin_bit_cast(bf16x8, bv), oT);
            }
#pragma unroll
        for (int s2 = 0; s2 < 2; ++s2) {
            u32x4 av; av[0] = vc_lo[s2][0]; av[1] = vc_lo[s2][1]; av[2] = vc_hi[s2][0]; av[3] = vc_hi[s2][1];
            oT = mfma32(__builtin_bit_cast(bf16x8, av), pb[s2], oT);
        }
        {
            float* op = OUT + (size_t)(tok0 + r31) * 1024 + hh * 256 + wave * 32 + 4 * h;
#pragma unroll
            for (int g = 0; g < 4; ++g) { f32x4 v; v[0] = oT[4 * g]; v[1] = oT[4 * g + 1]; v[2] = oT[4 * g + 2]; v[3] = oT[4 * g + 3]; *(f32x4*)(op + 8 * g) = v; }
        }
#pragma unroll
        for (int s2 = 0; s2 < 2; ++s2) {
#pragma unroll
            for (int dt = 0; dt < 4; ++dt) {
                const bf16x8 a = *(const LAS bf16x8*)(B + G_KDT + ((32 * dt + r31) * 40 + 16 * s2 + 8 * h) * 2);
                S[dt] = mfma32(a, vc_b[s2], S[dt]);
            }
        }
#pragma unroll
        for (int dt = 0; dt < 4; ++dt)
#pragma unroll
            for (int g = 0; g < 4; ++g) {
                const f32x4 ad = *(const LAS f32x4*)(B + G_AD + (32 * dt + 8 * g + 4 * h) * 4);
                S[dt][4 * g] *= ad[0]; S[dt][4 * g + 1] *= ad[1]; S[dt][4 * g + 2] *= ad[2]; S[dt][4 * g + 3] *= ad[3];
            }
        if (c + 1 < nch) {
            prep_finish(buf ^ 1);
#pragma unroll
            for (int s2 = 0; s2 < 2; ++s2) { vc_lo[s2] = vn_lo[s2]; vc_hi[s2] = vn_hi[s2]; vc_b[s2] = vn_b[s2]; }
        }
        __syncthreads();
    }
    if (!lat) {
        float* st = (dir ? P.new_b_b : P.new_b_f) + (size_t)(sidx * 4 + hh) * 128 * 256 + wave * 32 + r31;
#pragma unroll
        for (int dt = 0; dt < 4; ++dt)
#pragma unroll
            for (int i = 0; i < 16; ++i) st[(size_t)(32 * dt + (i & 3) + 8 * (i >> 2) + 4 * h) * 256] = S[dt][i];
    }
}

__device__ __forceinline__ void phase_mix0(CParams& P, LAS unsigned char* lds) {
    if (blockIdx.x < 144) gla_item(P, lds, blockIdx.x);
    if (blockIdx.x < 16) return;
    const float* lp = P.a_lambda;
    float s1 = 0.f, s2 = 0.f;
    for (int i = 0; i < 64; ++i) { s1 += lp[i] * lp[64 + i]; s2 += lp[128 + i] * lp[192 + i]; }
    const float lam_init = 0.2f, lam = __expf(s1) - __expf(s2) + lam_init;
    const int b = blockIdx.x;
    int first, second = -1;
    if (gridDim.x == 256) {
        if (b >= 144) { first = b - 144; if (b - 144 < 16) second = 240 + (b - 144); }
        else if (b < 32) first = 112 + (b - 16);
        else first = 128 + (b - 32);
        for (int k = 0; k < 2; ++k) { const int it = k ? second : first; if (it >= 0) diff_attn_item(P, lds, it, lam, lam_init); }
    } else {
        for (int it = b - 16; it < 256; it += gridDim.x - 16) diff_attn_item(P, lds, it, lam, lam_init);
    }
}
__device__ __forceinline__ void phase_mix1(CParams& P, LAS unsigned char* lds) {
    for (int it = blockIdx.x; it < 512; it += gridDim.x) sink_attn_item(P, lds, it);
}


#define XB_TMO      128
#define XB_XCNT(j)  (256  + 64 * (j))
#define XB_XSUB(j)  (1280 + 64 * (j))
#define XB_XGEN(j)  (2304 + 64 * (j))
#define XB_TOP      3328
#define XB_TOPGEN   3392
#define XCD_BAR_WORDS 3456
#define XB_SPIN_CAP (1u << 18)
__device__ __forceinline__ unsigned xb_ld(unsigned* p)              { return __hip_atomic_load(p, __ATOMIC_RELAXED, __HIP_MEMORY_SCOPE_AGENT); }
__device__ __forceinline__ unsigned xb_add(unsigned* p, unsigned v) { return __hip_atomic_fetch_add(p, v, __ATOMIC_RELAXED, __HIP_MEMORY_SCOPE_AGENT); }
__device__ __forceinline__ unsigned xb_xcc_id() { return (unsigned)__builtin_amdgcn_s_getreg((3 << 11) | 20) & 0xFu; }
#define XB_SPIN(cond, bar) do { unsigned _sp = 0; while (cond) { __builtin_amdgcn_s_sleep(1); \
    if ((++_sp & 255u) == 0u) { if (xb_ld(&(bar)[XB_TMO])) break; if (_sp > XB_SPIN_CAP) { atomicAdd(&(bar)[XB_TMO], 1u); break; } } } } while (0)
struct XcdBarrier { unsigned* bar; unsigned x; volatile LAS unsigned* st; };
__device__ __forceinline__ XcdBarrier xcd_barrier_post(unsigned* bar, volatile LAS unsigned* st) {
    XcdBarrier b; b.bar = bar; b.x = xb_xcc_id(); b.st = st;
    if (threadIdx.x == 0) (void)xb_add(&bar[XB_XCNT(b.x)], 1u);
    return b;
}
__device__ __forceinline__ void xcd_barrier_complete(unsigned* bar, unsigned x, unsigned& nloc, unsigned& nx) {
    const unsigned G = gridDim.x * gridDim.y * gridDim.z;
    unsigned sum, cnt, mine, sp = 0u;
    for (;;) {
        sum = 0u; cnt = 0u; mine = 0u;
#pragma unroll
        for (unsigned j = 0; j < 16; ++j) { const unsigned c = xb_ld(&bar[XB_XCNT(j)]); sum += c; cnt += (c > 0u) ? 1u : 0u; mine = (j == x) ? c : mine; }
        if (sum == G) break;
        __builtin_amdgcn_s_sleep(1);
        if ((++sp & 255u) == 0u) { if (xb_ld(&bar[XB_TMO])) break; if (sp > XB_SPIN_CAP) { atomicAdd(&bar[XB_TMO], 1u); break; } }
    }
    nloc = mine > 0u ? mine : 1u; nx = cnt > 0u ? cnt : 1u;
}
__device__ __forceinline__ void xcd_barrier(const XcdBarrier& b) {
    asm volatile("s_waitcnt vmcnt(0)" ::: "memory");
    __syncthreads();
    if (threadIdx.x == 0) {
        unsigned* bar = b.bar;
        __builtin_amdgcn_s_waitcnt(0);
        unsigned nloc = b.st[0], nx = b.st[1];
        if (nloc == 0u) { xcd_barrier_complete(bar, b.x, nloc, nx); b.st[0] = nloc; b.st[1] = nx; }
        const unsigned old = xb_add(&bar[XB_XSUB(b.x)], 1u);
        const unsigned gen = old / nloc;
        if (old + 1u == (gen + 1u) * nloc) {
            __builtin_amdgcn_fence(__ATOMIC_RELEASE, "agent");
            asm volatile("s_waitcnt vmcnt(0)" ::: "memory");
            const unsigned og = xb_add(&bar[XB_TOP], 1u);
            const unsigned tg = og / nx;
            if (og + 1u == (tg + 1u) * nx) xb_add(&bar[XB_TOPGEN], 1u);
            else XB_SPIN(xb_ld(&bar[XB_TOPGEN]) == tg, bar);
            __builtin_amdgcn_fence(__ATOMIC_ACQUIRE, "agent");
            xb_add(&bar[XB_XGEN(b.x)], 1u);
            asm volatile("s_waitcnt vmcnt(0)" ::: "memory");
        } else {
            XB_SPIN(xb_ld(&bar[XB_XGEN(b.x)]) == gen, bar);
            __builtin_amdgcn_fence(__ATOMIC_ACQUIRE, "agent");
            asm volatile("s_waitcnt vmcnt(0)" ::: "memory");
        }
    }
    __syncthreads();
}

__global__ void __launch_bounds__(512, 2) fwd_megakernel(const Params Pk) {
    extern __shared__ __attribute__((aligned(16))) unsigned char shm[];
    LAS unsigned char* lds = (LAS unsigned char*)shm;
    cg::grid_group grid = cg::this_grid();
    CParams* kp = (CParams*)__builtin_amdgcn_kernarg_segment_ptr();
    const int phase_lo = Pk.phase_lo, phase_hi = Pk.phase_hi;
    int ph = 0;
    volatile LAS unsigned* xst = (volatile LAS unsigned*)(lds + pg8::STAGE_BYTES);
    if (threadIdx.x < 4) xst[threadIdx.x] = 0u;
    __syncthreads();
    const XcdBarrier xb = xcd_barrier_post(Pk.bar, xst);
#define PHASE(...) do { if (ph >= phase_lo && ph < phase_hi) { { CParams* pp = kp; asm volatile("" : "+s"(pp)); CParams& P = *pp; __VA_ARGS__; } if (ph + 1 < phase_hi) { if (ph == 0) grid.sync(); else xcd_barrier(xb); if (REP_SYNC >= 2) xcd_barrier(xb); } } ++ph; } while (0)
#define PHASE_R(REP, ...) do { PHASE(__VA_ARGS__); if ((REP) >= 2) PHASE(__VA_ARGS__); } while (0)
#define GEMM(EpiT, epi, Aptr, Btptr, Nn, Kk) do { pg8::Gemm g{Aptr, Btptr, NTOK, Nn, Kk}; pg8::StaticOrder S; S.init(NTOK, Nn, gridDim.x, blockIdx.x); EpiT E = epi; pg8::gemm_phase<EpiT>(lds, g, S, E); } while (0)
#define LATE_SLOT(k) do { if (gridDim.x == 256 ? blockIdx.x >= 128 : (k) == 0) { const int sp_ = IT_E0 + P.n_early / 2, nl_ = 144 + (P.n_ttiles - P.n_early) / 2; \
        if (gridDim.x == 256) run_prep_items(P, lds, sp_ + (nl_ * (k)) / 3 + (blockIdx.x - 128), sp_ + (nl_ * ((k) + 1)) / 3, 128); \
        else run_prep_items(P, lds, sp_ + blockIdx.x, sp_ + nl_, gridDim.x); } } while (0)
#define LAYER_HEAD(l) \
        PHASE_R(REP_NORM, phase_norm(P, l, 0, 0)); \
        PHASE_R(REP_FFNIN, GEMM(EpiSwiGLU, (EpiSwiGLU{P.act}), P.h, P.wt_in + (size_t)(l * 2) * 2 * DFF * DM, 2 * DFF, DM)); \
        PHASE(GEMM(EpiResid, (EpiResid{&P, l, 2, 0.5f}), P.act, P.wt_out + (size_t)(l * 2) * DM * DFF, DM, DFF)); \
        PHASE_R(REP_NORM, phase_norm(P, l, 1, 3));
#define LAYER_TAIL(l) \
        PHASE_R(REP_NORM, phase_norm(P, l, 2, 6)); \
        PHASE_R(REP_FFNIN, GEMM(EpiSwiGLU, (EpiSwiGLU{P.act}), P.h, P.wt_in + (size_t)(l * 2 + 1) * 2 * DFF * DM, 2 * DFF, DM)); \
        PHASE(GEMM(EpiResid, (EpiResid{&P, l, 8, 0.5f}), P.act, P.wt_out + (size_t)(l * 2 + 1) * DM * DFF, DM, DFF));
    PHASE_R(REP_PREP, run_prep_items(P, lds, blockIdx.x, IT_E0 + P.n_early / 2, gridDim.x));
    PHASE(phase_norm(P, 0, 0, 0));
    PHASE(GEMM(EpiSwiGLU, (EpiSwiGLU{P.act}), P.h, P.wt_in, 2 * DFF, DM); LATE_SLOT(0));
    PHASE(GEMM(EpiResid, (EpiResid{&P, 0, 2, 0.5f}), P.act, P.wt_out, DM, DFF));
    PHASE(phase_norm(P, 0, 1, 3));
    PHASE(GEMM(EpiAB, (EpiAB{&P}), P.h, P.wt_ab, 7168, DM); LATE_SLOT(1));
    PHASE_R(REP_MIX0, phase_mix0(P, lds));
    PHASE_R(REP_NORM, phase_gla_merge(P));
    PHASE(GEMM(EpiResid, (EpiResid{&P, 0, 5, 1.0f}), P.mo, P.wt_abo, DM, DM));
    PHASE(phase_norm(P, 0, 2, 6));
    PHASE(GEMM(EpiSwiGLU, (EpiSwiGLU{P.act}), P.h, P.wt_in + (size_t)1 * 2 * DFF * DM, 2 * DFF, DM); LATE_SLOT(2));
    PHASE(GEMM(EpiResid, (EpiResid{&P, 0, 8, 0.5f}), P.act, P.wt_out + (size_t)1 * DM * DFF, DM, DFF));
    LAYER_HEAD(1)
    PHASE(GEMM(EpiC, (EpiC{&P}), P.h, P.wt_c, 3072, DM));
    PHASE_R(REP_MIX1, phase_mix1(P, lds));
    PHASE(GEMM(EpiResid, (EpiResid{&P, 1, 5, 1.0f}), P.mo, P.wt_co, DM, DM));
    LAYER_TAIL(1)
    PHASE_R(REP_NORM, phase_final_norm(P));
}
constexpr int N_PHASES = 1 + 11 + 10 + 1;

extern "C" void kernel_launch(void* const* d_in, const int* in_sizes, int n_in, void* d_out, int out_size, void* d_ws, size_t ws_size, hipStream_t stream) {
    Params p; memset(&p, 0, sizeof(p));
    const float* const* in = (const float* const*)d_in;
    p.x_prompt = in[0]; p.x_sample = in[1]; p.cache_a_k = in[2]; p.cache_a_v = in[3]; p.state_f = in[4]; p.state_b = in[5]; p.cache_c_k = in[6]; p.cache_c_v = in[7]; p.c = in[8]; p.c_ctx = in[9];
    p.ada_w = in[10]; p.ada_b = in[11]; p.norm_g = in[12]; p.ffn_w_in = in[13]; p.ffn_w_out = in[14]; p.ab_w_in = in[15]; p.ab_w_out = in[16]; p.a_lambda = in[17]; p.a_subln_g = in[18];
    p.alpha_w = in[19]; p.alpha_b = in[20]; p.b_norm_g = in[21]; p.c_w_in = in[22]; p.c_w_out = in[23]; p.c_sink = in[24]; p.final_g = in[25];
    float* out = (float*)d_out;
    p.y = out; p.new_a_k = out + 16777216; p.new_a_v = p.new_a_k + 4194304; p.new_b_f = p.new_a_v + 4194304; p.new_b_b = p.new_b_f + 2097152; p.new_c_k = p.new_b_b + 2097152; p.new_c_v = p.new_c_k + 2097152;
    char* w = (char*)d_ws; size_t off = 0;
    auto take = [&](size_t bytes) { char* r = w + off; off += (bytes + 255) & ~(size_t)255; return r; };
    p.mods = (float*)take((size_t)2 * 2 * 3 * NMODW * 4);
    p.xres = (float*)take((size_t)NTOK * DM * 4);
    p.h = (bf16_t*)take((size_t)NTOK * DM * 2);
    p.act = (bf16_t*)take((size_t)NTOK * DFF * 2);
    p.mo = (bf16_t*)take((size_t)NTOK * DM * 2);
    p.wt_in = (bf16_t*)take((size_t)4 * 2 * DFF * DM * 2);
    p.wt_out = (bf16_t*)take((size_t)4 * DM * DFF * 2);
    p.wt_ab = (bf16_t*)take((size_t)7168 * DM * 2);
    p.wt_abo = (bf16_t*)take((size_t)DM * DM * 2);
    p.wt_c = (bf16_t*)take((size_t)3072 * DM * 2);
    p.wt_co = (bf16_t*)take((size_t)DM * DM * 2);
    p.qa_p = (bf16_t*)take((size_t)16 * 8 * 256 * 128 * 2); p.ka_p = (bf16_t*)take((size_t)16 * 8 * 256 * 128 * 2); p.vta_p = (bf16_t*)take((size_t)16 * 8 * 256 * 128 * 2);
    p.qa_s = (bf16_t*)take((size_t)2 * 8 * 2048 * 128 * 2); p.ka_s = (bf16_t*)take((size_t)2 * 8 * 2560 * 128 * 2); p.vta_s = (bf16_t*)take((size_t)2 * 8 * 2560 * 128 * 2);
    p.qc_p = (bf16_t*)take((size_t)16 * 16 * 256 * 128 * 2); p.kc_p = (bf16_t*)take((size_t)16 * 4 * 256 * 128 * 2); p.vtc_p = (bf16_t*)take((size_t)16 * 4 * 256 * 128 * 2);
    p.qc_s = (bf16_t*)take((size_t)2 * 16 * 2048 * 128 * 2); p.kc_s = (bf16_t*)take((size_t)2 * 4 * 2560 * 128 * 2); p.vtc_s = (bf16_t*)take((size_t)2 * 4 * 2560 * 128 * 2);
    p.pb = (bf16_t*)take((size_t)NTOK * 3072 * 2);
    p.bvt = (bf16_t*)take((size_t)1024 * NTOK * 2);
    p.la = (float*)take((size_t)NTOK * 1024 * 4);
    p.lacum = (float*)take((size_t)NTOK * 1024 * 4);
    p.of = (float*)take((size_t)NTOK * 1024 * 4);
    p.ob = (float*)take((size_t)NTOK * 1024 * 4);
    p.park = (float*)take((size_t)512 * 16 * 512 * 16);
    p.bar = (unsigned*)take((size_t)XCD_BAR_WORDS * 4);
    int nj = 0, t0 = 0;
    auto job = [&](const float* src, bf16_t* dst, int lds_, int K, int N, int ldd, int map, int nb, long long sbs, long long dbs) {
        TJob& J = p.jobs[nj++]; J.src = src; J.dst = dst; J.lds = lds_; J.K = K; J.N = N; J.ldd = ldd; J.map = map; J.nbatch = nb; J.sbs = sbs; J.dbs = dbs; J.tile0 = t0; J.pad = 0;
        t0 += nb * (K / 128) * (N / 128);
    };
    auto job_in = [&](int i) { job(p.ffn_w_in + (size_t)i * DM * 2 * DFF, p.wt_in + (size_t)i * 2 * DFF * DM, 2 * DFF, DM, 2 * DFF, DM, 1, 1, 0, 0); };
    auto job_out = [&](int i) { job(p.ffn_w_out + (size_t)i * DFF * DM, p.wt_out + (size_t)i * DM * DFF, DM, DFF, DM, DFF, 0, 1, 0, 0); };
    job_in(0); job_in(1); job_out(0); job_out(1);
    job(p.ab_w_in, p.wt_ab, 6176, DM, 6144, DM, 0, 1, 0, 0);
    job(p.ab_w_out, p.wt_abo, DM, DM, DM, DM, 0, 1, 0, 0);
    job(p.cache_a_v, p.vta_s, 128, 512, 128, 2560, 0, 16, 512 * 128, 128 * 2560);
    job(p.cache_c_v, p.vtc_s, 128, 512, 128, 2560, 0, 8, 512 * 128, 128 * 2560);
    p.n_early = t0;
    job_in(2); job_in(3); job_out(2); job_out(3);
    job(p.c_w_in, p.wt_c, 3072, DM, 3072, DM, 2, 1, 0, 0);
    job(p.c_w_out, p.wt_co, DM, DM, DM, DM, 0, 1, 0, 0);
    p.n_ttiles = t0;

    constexpr size_t kDynLds = pg8::STAGE_BYTES + 16;
    static int grid_blocks = 0;
    if (!grid_blocks) {
        int dev = 0, cus = 0, per_cu = 0;
        hipGetDevice(&dev);
        hipDeviceGetAttribute(&cus, hipDeviceAttributeMultiprocessorCount, dev);
        hipFuncSetAttribute((const void*)fwd_megakernel, hipFuncAttributeMaxDynamicSharedMemorySize, (int)kDynLds);
        hipOccupancyMaxActiveBlocksPerMultiprocessor(&per_cu, fwd_megakernel, 512, kDynLds);
        if (per_cu < 1) per_cu = 1;
        grid_blocks = cus * 1;
    }
#if N_LAUNCH_SPLIT
    for (int ph = 0; ph < N_PHASES; ++ph) {
        p.phase_lo = ph; p.phase_hi = ph + 1;
        hipLaunchKernelGGL(fwd_megakernel, dim3(grid_blocks), dim3(512), kDynLds, stream, p);
    }
#else
    p.phase_lo = 0; p.phase_hi = 1 << 20;
    (void)hipMemsetAsync(p.bar, 0, (size_t)XCD_BAR_WORDS * 4, stream);
    void* args[] = {&p};
    hipError_t e = hipLaunchCooperativeKernel((const void*)fwd_megakernel, dim3(grid_blocks), dim3(512), args, kDynLds, stream);
    if (e != hipSuccess) fprintf(stderr, "cooperative launch failed: %s (grid %d)\n", hipGetErrorString(e), grid_blocks);
#endif
}
```
